# Optimizing an MI355X kernel written in HIP

```python
import math
import jax
import jax.numpy as jnp
from jax import lax
import numpy as np


D_MODEL = 2048
BATCH = 4
SEQ = 2048
DEPTH = 2

GRID_W = 64
CTX_LEN = 256
EPS = 1e-6
ROPE_BASE = 10000.0
NEG_INF = -1e30
BLOCK = 128
HEAD_DIM = 128
S5_WIDTH = D_MODEL // 4
S5_GROUP = 16
S5_GROUPS = S5_WIDTH // S5_GROUP
S5_STATE = 64
SWA_HEADS = (3 * D_MODEL // 8) // HEAD_DIM
SWA_KV_HEADS = 2
WINDOW = 128
MLA_HEADS = (3 * D_MODEL // 8) // 128
MLA_Q_RANK = 768
MLA_KV_RANK = 512
MLA_NOPE = 128
MLA_ROPE = 64
MLA_V = 128
MIX_WIDTH = S5_WIDTH + SWA_HEADS * HEAD_DIM + MLA_HEADS * MLA_V
D_FF = 4 * D_MODEL
IN_WIDTHS = (S5_WIDTH, SWA_HEADS * HEAD_DIM, SWA_KV_HEADS * HEAD_DIM, SWA_KV_HEADS * HEAD_DIM,
             MLA_Q_RANK, MLA_KV_RANK, MLA_ROPE)
IN_WIDTH = sum(IN_WIDTHS)

kernel_name = 'hybrid_s5_swa_mla_prefix_dit_block'


def rms_norm(x, g):
    xf = x.astype(jnp.float32)
    y = xf * lax.rsqrt(jnp.mean(xf * xf, axis=-1, keepdims=True) + EPS)
    return (y * g.astype(jnp.float32)).astype(x.dtype)


def modulate(h, shift, scale):
    return h * (1.0 + scale) + shift


def split_in(z):
    out, off = [], 0
    for w in IN_WIDTHS:
        out.append(z[..., off:off + w])
        off += w
    return out


def axial_angles(row, col, rot_dim):
    quarter = rot_dim // 4
    inv_freq = ROPE_BASE ** (-jnp.arange(quarter, dtype=jnp.float32) / quarter)
    return (row.astype(jnp.float32)[:, None] * inv_freq, col.astype(jnp.float32)[:, None] * inv_freq)


def _rotate(x, ang):
    x1, x2 = jnp.split(x.astype(jnp.float32), 2, axis=-1)
    cos = jnp.cos(ang)[:, None, :]
    sin = jnp.sin(ang)[:, None, :]
    return jnp.concatenate([x1 * cos - x2 * sin, x2 * cos + x1 * sin], axis=-1)


def rope_2d(x, ang_row, ang_col):
    xr, xc = jnp.split(x, 2, axis=-1)
    return jnp.concatenate([_rotate(xr, ang_row), _rotate(xc, ang_col)], axis=-1).astype(x.dtype)


def s5_discretize(a_re, a_im, log_dt, b_re, b_im):
    dt = jnp.exp(log_dt)[:, None]
    mag = jnp.exp(a_re * dt)
    lr = mag * jnp.cos(a_im * dt)
    li = mag * jnp.sin(a_im * dt)
    den = a_re * a_re + a_im * a_im
    nr = lr - 1.0
    fr = (nr * a_re + li * a_im) / den
    fi = (li * a_re - nr * a_im) / den
    bb_r = fr[..., None] * b_re - fi[..., None] * b_im
    bb_i = fr[..., None] * b_im + fi[..., None] * b_re
    return lr, li, bb_r, bb_i


def _complex_affine_combine(e1, e2):
    a1r, a1i, b1r, b1i = e1
    a2r, a2i, b2r, b2i = e2
    return (a2r * a1r - a2i * a1i, a2r * a1i + a2i * a1r,
            a2r * b1r - a2i * b1i + b2r, a2r * b1i + a2i * b1r + b2i)


def s5_states(u, lam_r, lam_i, bb_r, bb_i, h0):
    b_r = jnp.einsum('btgp,gnp->btgn', u, bb_r)
    b_i = jnp.einsum('btgp,gnp->btgn', u, bb_i)
    if h0 is not None:
        h0_r, h0_i = h0
        b_r = b_r.at[:, 0].add(lam_r * h0_r - lam_i * h0_i)
        b_i = b_i.at[:, 0].add(lam_r * h0_i + lam_i * h0_r)
    a_r = jnp.broadcast_to(lam_r, b_r.shape)
    a_i = jnp.broadcast_to(lam_i, b_i.shape)
    _, _, h_r, h_i = lax.associative_scan(_complex_affine_combine, (a_r, a_i, b_r, b_i), axis=1)
    return h_r, h_i


def s5_readout(h_r, h_i, c_r, c_i):
    return jnp.einsum('btgn,gpn->btgp', h_r, c_r) - jnp.einsum('btgn,gpn->btgp', h_i, c_i)


def _order(t, reverse):
    return jnp.flip(t, axis=1) if reverse else t


def s5_mixer(u_c, u_l, a_re, a_im, log_dt, b_re, b_im, c_re, c_im, d_skip, glu_w, glu_b, need_ctx):
    f32 = jnp.float32
    uc = u_c.astype(f32).reshape(u_c.shape[0], u_c.shape[1], S5_GROUPS, S5_GROUP)
    ul = u_l.astype(f32).reshape(u_l.shape[0], u_l.shape[1], S5_GROUPS, S5_GROUP)
    dk = d_skip.astype(f32)
    y_l = dk * u_l.astype(f32)
    y_c = dk * u_c.astype(f32)
    for direction in range(2):
        rev = direction == 1
        lam_r, lam_i, bb_r, bb_i = s5_discretize(a_re[direction].astype(f32), a_im[direction].astype(f32),
                                                 log_dt[direction].astype(f32), b_re[direction].astype(f32),
                                                 b_im[direction].astype(f32))
        cr = c_re[direction].astype(f32)
        ci = c_im[direction].astype(f32)
        hc_r, hc_i = s5_states(_order(uc, rev), lam_r, lam_i, bb_r, bb_i, None)
        hl_r, hl_i = s5_states(_order(ul, rev), lam_r, lam_i, bb_r, bb_i, (hc_r[:, -1], hc_i[:, -1]))
        y_l = y_l + _order(s5_readout(hl_r, hl_i, cr, ci), rev).reshape(y_l.shape)
        if need_ctx:
            y_c = y_c + _order(s5_readout(hc_r, hc_i, cr, ci), rev).reshape(y_c.shape)

    def glu(y):
        g = jax.nn.gelu(y)
        return (g * jax.nn.sigmoid(g @ glu_w.astype(f32) + glu_b.astype(f32))).astype(u_l.dtype)

    return (glu(y_c) if need_ctx else None), glu(y_l)


def swa_latent(q, k, v, kc, vc, sink):
    f32 = jnp.float32
    bsz, n, n_heads, dh = q.shape
    n_kv = k.shape[2]
    rep = n_heads // n_kv
    nb = n // BLOCK
    n_ctx = kc.shape[1]
    scale = dh ** -0.5
    qb = q.reshape(bsz, nb, BLOCK, n_kv, rep, dh)

    def band(t):
        tp = jnp.pad(t, ((0, 0), (BLOCK, BLOCK), (0, 0), (0, 0))).reshape(bsz, nb + 2, BLOCK, n_kv, dh)
        return jnp.concatenate([tp[:, :-2], tp[:, 1:-1], tp[:, 2:]], axis=2)

    kb, vb = band(k), band(v)
    s_ctx = jnp.einsum('bnqgrd,bcgd->bgrnqc', qb, kc).astype(f32) * scale
    s_band = jnp.einsum('bnqgrd,bnkgd->bgrnqk', qb, kb).astype(f32) * scale
    blk = jnp.arange(nb)[:, None, None] * BLOCK
    qpos = blk + jnp.arange(BLOCK)[None, :, None]
    kpos = blk - BLOCK + jnp.arange(3 * BLOCK)[None, None, :]
    valid = (jnp.abs(qpos - kpos) <= WINDOW) & (kpos >= 0) & (kpos < n)
    s_band = jnp.where(valid, s_band, NEG_INF)
    s_sink = jnp.broadcast_to(sink.astype(f32).reshape(1, n_kv, rep, 1, 1, 1), s_band.shape[:-1] + (1,))
    p = jax.nn.softmax(jnp.concatenate([s_ctx, s_band, s_sink], axis=-1), axis=-1).astype(v.dtype)
    o = (jnp.einsum('bgrnqc,bcgd->bnqgrd', p[..., :n_ctx], vc)
         + jnp.einsum('bgrnqk,bnkgd->bnqgrd', p[..., n_ctx:n_ctx + 3 * BLOCK], vb))
    return o.reshape(bsz, n, n_heads * dh)


def swa_context(qc, kc, vc, sink):
    f32 = jnp.float32
    bsz, n_ctx, n_heads, dh = qc.shape
    n_kv = kc.shape[2]
    rep = n_heads // n_kv
    qg = qc.reshape(bsz, n_ctx, n_kv, rep, dh)
    s = jnp.einsum('bqgrd,bkgd->bgrqk', qg, kc).astype(f32) * (dh ** -0.5)
    s_sink = jnp.broadcast_to(sink.astype(f32).reshape(1, n_kv, rep, 1, 1), s.shape[:-1] + (1,))
    p = jax.nn.softmax(jnp.concatenate([s, s_sink], axis=-1), axis=-1)[..., :n_ctx].astype(vc.dtype)
    return jnp.einsum('bgrqk,bkgd->bqgrd', p, vc).reshape(bsz, n_ctx, n_heads * dh)


def mla_queries(z_cq, q_norm, w_uq, ang):
    bsz, t, _ = z_cq.shape
    q = (rms_norm(z_cq, q_norm) @ w_uq).reshape(bsz, t, MLA_HEADS, MLA_NOPE + MLA_ROPE)
    q_nope, q_rope = q[..., :MLA_NOPE], q[..., MLA_NOPE:]
    if ang is not None:
        q_rope = rope_2d(q_rope, ang[0], ang[1])
    return q_nope, q_rope


def mla_keys(z_ckv, k_rope, kv_norm, w_ukv, ang):
    bsz, t, _ = z_ckv.shape
    kv = (rms_norm(z_ckv, kv_norm) @ w_ukv).reshape(bsz, t, MLA_HEADS, MLA_NOPE + MLA_V)
    k_nope, v = kv[..., :MLA_NOPE], kv[..., MLA_NOPE:]
    if ang is not None:
        k_rope = rope_2d(k_rope[:, :, None, :], ang[0], ang[1])[:, :, 0, :]
    return k_nope, k_rope, v


def mla_attend(q_nope, q_rope, k_nope, k_rope, v):
    bsz, n_q, n_heads, _ = q_nope.shape
    nb = n_q // BLOCK
    scale = (MLA_NOPE + MLA_ROPE) ** -0.5

    def to_blocks(t):
        return jnp.moveaxis(t.reshape((bsz, nb, BLOCK) + t.shape[2:]), 1, 0)

    def one_block(args):
        qn, qr = args
        s = (jnp.einsum('bqhd,bkhd->bhqk', qn, k_nope)
             + jnp.einsum('bqhd,bkd->bhqk', qr, k_rope)).astype(jnp.float32) * scale
        p = jax.nn.softmax(s, axis=-1).astype(v.dtype)
        return jnp.einsum('bhqk,bkhd->bqhd', p, v)

    o = lax.map(one_block, (to_blocks(q_nope), to_blocks(q_rope)))
    return jnp.moveaxis(o, 0, 1).reshape(bsz, n_q, n_heads * MLA_V)


def hybrid_mixer(h_c, h_l, w_in, w_out, s5_p, swa_sink, mla_p, ang_swa, ang_mla, need_ctx):
    bsz, n, _ = h_l.shape
    n_ctx = h_c.shape[1]
    u_l, qs_l, ks_l, vs_l, cq_l, ckv_l, kr_l = split_in(h_l @ w_in)
    u_c, qs_c, ks_c, vs_c, cq_c, ckv_c, kr_c = split_in(h_c @ w_in)
    q_norm, w_uq, kv_norm, w_ukv = mla_p

    s5_c, s5_l = s5_mixer(u_c, u_l, *s5_p, need_ctx)

    q_l = rope_2d(qs_l.reshape(bsz, n, SWA_HEADS, HEAD_DIM), ang_swa[0], ang_swa[1])
    k_l = rope_2d(ks_l.reshape(bsz, n, SWA_KV_HEADS, HEAD_DIM), ang_swa[0], ang_swa[1])
    v_l = vs_l.reshape(bsz, n, SWA_KV_HEADS, HEAD_DIM)
    k_c = ks_c.reshape(bsz, n_ctx, SWA_KV_HEADS, HEAD_DIM)
    v_c = vs_c.reshape(bsz, n_ctx, SWA_KV_HEADS, HEAD_DIM)
    swa_l = swa_latent(q_l, k_l, v_l, k_c, v_c, swa_sink)

    qn_l, qr_l = mla_queries(cq_l, q_norm, w_uq, ang_mla)
    kn_l, kro_l, vm_l = mla_keys(ckv_l, kr_l, kv_norm, w_ukv, ang_mla)
    kn_c, kro_c, vm_c = mla_keys(ckv_c, kr_c, kv_norm, w_ukv, None)
    mla_l = mla_attend(qn_l, qr_l, jnp.concatenate([kn_c, kn_l], axis=1),
                       jnp.concatenate([kro_c, kro_l], axis=1), jnp.concatenate([vm_c, vm_l], axis=1))

    o_l = jnp.concatenate([s5_l, swa_l, mla_l], axis=-1) @ w_out
    if not need_ctx:
        return None, o_l
    swa_c = swa_context(qs_c.reshape(bsz, n_ctx, SWA_HEADS, HEAD_DIM), k_c, v_c, swa_sink)
    qn_c, qr_c = mla_queries(cq_c, q_norm, w_uq, None)
    mla_c = mla_attend(qn_c, qr_c, kn_c, kro_c, vm_c)
    o_c = jnp.concatenate([s5_c, swa_c, mla_c], axis=-1) @ w_out
    return o_c, o_l


def sqrelu_mlp(h, w1, w2):
    return jnp.square(jax.nn.relu(h @ w1)) @ w2


def setup_inputs(seed: int = 0) -> dict:
    key = jax.random.key(seed)
    ks = jax.random.split(key, 32)
    f32 = jnp.float32

    def nrm(k, shape, scale):
        return jax.random.normal(k, shape, f32) * scale

    G, N, P = S5_GROUPS, S5_STATE, S5_GROUP
    return {
        'x': nrm(ks[0], (BATCH, SEQ, D_MODEL), 1.0),
        'c': nrm(ks[1], (BATCH, D_MODEL), 1.0),
        'ctx': nrm(ks[2], (BATCH, CTX_LEN, D_MODEL), 1.0),
        'c_ctx': nrm(ks[3], (D_MODEL,), 1.0),
        'ada_w': nrm(ks[4], (DEPTH, D_MODEL, 6 * D_MODEL), D_MODEL ** -0.5),
        'ada_b': nrm(ks[5], (DEPTH, 6 * D_MODEL), 0.02),
        'norm_mix_pre': 1.0 + nrm(ks[6], (DEPTH, D_MODEL), 0.05),
        'norm_mix_post': 1.0 + nrm(ks[7], (DEPTH, D_MODEL), 0.05),
        'norm_ffn_pre': 1.0 + nrm(ks[8], (DEPTH, D_MODEL), 0.05),
        'norm_ffn_post': 1.0 + nrm(ks[9], (DEPTH, D_MODEL), 0.05),
        'w_in': nrm(ks[10], (DEPTH, D_MODEL, IN_WIDTH), D_MODEL ** -0.5),
        'w_out': nrm(ks[11], (DEPTH, MIX_WIDTH, D_MODEL), MIX_WIDTH ** -0.5),
        's5_a_re': -0.5 + nrm(ks[12], (DEPTH, 2, G, N), 0.01),
        's5_a_im': math.pi * jnp.arange(N, dtype=f32) + nrm(ks[13], (DEPTH, 2, G, N), 0.01),
        's5_log_dt': jax.random.uniform(ks[14], (DEPTH, 2, G), f32, minval=math.log(1e-3), maxval=math.log(1e-1)),
        's5_b_re': nrm(ks[15], (DEPTH, 2, G, N, P), (2.0 * P) ** -0.5),
        's5_b_im': nrm(ks[16], (DEPTH, 2, G, N, P), (2.0 * P) ** -0.5),
        's5_c_re': nrm(ks[17], (DEPTH, 2, G, P, N), (2.0 * N) ** -0.5),
        's5_c_im': nrm(ks[18], (DEPTH, 2, G, P, N), (2.0 * N) ** -0.5),
        's5_d': nrm(ks[19], (DEPTH, S5_WIDTH), 0.5),
        's5_glu_w': nrm(ks[20], (DEPTH, S5_WIDTH, S5_WIDTH), S5_WIDTH ** -0.5),
        's5_glu_b': nrm(ks[21], (DEPTH, S5_WIDTH), 0.02),
        'swa_sink': nrm(ks[22], (DEPTH, SWA_HEADS), 0.5),
        'mla_q_norm': 1.0 + nrm(ks[23], (DEPTH, MLA_Q_RANK), 0.05),
        'mla_w_uq': nrm(ks[24], (DEPTH, MLA_Q_RANK, MLA_HEADS * (MLA_NOPE + MLA_ROPE)), MLA_Q_RANK ** -0.5),
        'mla_kv_norm': 1.0 + nrm(ks[25], (DEPTH, MLA_KV_RANK), 0.05),
        'mla_w_ukv': nrm(ks[26], (DEPTH, MLA_KV_RANK, MLA_HEADS * (MLA_NOPE + MLA_V)), MLA_KV_RANK ** -0.5),
        'ffn_w1': nrm(ks[27], (DEPTH, D_MODEL, D_FF), D_MODEL ** -0.5),
        'ffn_w2': nrm(ks[28], (DEPTH, D_FF, D_MODEL), D_FF ** -0.5),
    }


def reference(x, c, ctx, c_ctx, ada_w, ada_b, norm_mix_pre, norm_mix_post, norm_ffn_pre, norm_ffn_post,
              w_in, w_out, s5_a_re, s5_a_im, s5_log_dt, s5_b_re, s5_b_im, s5_c_re, s5_c_im, s5_d,
              s5_glu_w, s5_glu_b, swa_sink, mla_q_norm, mla_w_uq, mla_kv_norm, mla_w_ukv, ffn_w1, ffn_w2):
    n_lat = x.shape[1]
    rows = n_lat // GRID_W
    row = jnp.repeat(jnp.arange(rows), GRID_W)
    col = jnp.tile(jnp.arange(GRID_W), rows)
    ang_swa = axial_angles(row, col, HEAD_DIM)
    ang_mla = axial_angles(row, col, MLA_ROPE)
    for i in range(DEPTH):
        need_ctx = i < DEPTH - 1
        mod_l = jnp.split((jax.nn.silu(c) @ ada_w[i] + ada_b[i])[:, None, :], 6, axis=-1)
        mod_c = jnp.split(jax.nn.silu(c_ctx) @ ada_w[i] + ada_b[i], 6, axis=-1)
        h_l = modulate(rms_norm(x, norm_mix_pre[i]), mod_l[0], mod_l[1])
        h_c = modulate(rms_norm(ctx, norm_mix_pre[i]), mod_c[0], mod_c[1])
        o_c, o_l = hybrid_mixer(
            h_c, h_l, w_in[i], w_out[i],
            (s5_a_re[i], s5_a_im[i], s5_log_dt[i], s5_b_re[i], s5_b_im[i], s5_c_re[i], s5_c_im[i],
             s5_d[i], s5_glu_w[i], s5_glu_b[i]),
            swa_sink[i],
            (mla_q_norm[i], mla_w_uq[i], mla_kv_norm[i], mla_w_ukv[i]),
            ang_swa, ang_mla, need_ctx)
        x = x + mod_l[2] * rms_norm(o_l, norm_mix_post[i])
        f_l = modulate(rms_norm(x, norm_ffn_pre[i]), mod_l[3], mod_l[4])
        x = x + mod_l[5] * rms_norm(sqrelu_mlp(f_l, ffn_w1[i], ffn_w2[i]), norm_ffn_post[i])
        if need_ctx:
            ctx = ctx + mod_c[2] * rms_norm(o_c, norm_mix_post[i])
            f_c = modulate(rms_norm(ctx, norm_ffn_pre[i]), mod_c[3], mod_c[4])
            ctx = ctx + mod_c[5] * rms_norm(sqrelu_mlp(f_c, ffn_w1[i], ffn_w2[i]), norm_ffn_post[i])
    return x
```

```cpp
#include <hip/hip_runtime.h>
#include <hip/hip_cooperative_groups.h>
#include <cstdio>
#include <cstdint>
namespace cg = cooperative_groups;

#define LAS __attribute__((address_space(3)))
typedef unsigned short bf16_t;
typedef short bf16x8 __attribute__((ext_vector_type(8)));
typedef float f32x4 __attribute__((ext_vector_type(4)));
typedef float f32x2 __attribute__((ext_vector_type(2)));
typedef unsigned u32x4 __attribute__((ext_vector_type(4)));
typedef unsigned u32x2 __attribute__((ext_vector_type(2)));

constexpr int DM = 2048, NBATCH = 4, SEQ = 2048, CTXL = 256, NKEY = SEQ + CTXL;
constexpr int ML = NBATCH * SEQ, MC = NBATCH * CTXL, MT = ML + MC;
constexpr int INW = 3136, INWP = 3328, DFF = 8192, UQW = 1152, UQWP = 1280, UKVW = 1536;
constexpr float EPSN = 1e-6f;
constexpr int LDS_BYTES = 131072 + 16;
constexpr int NWAVES = 8;

constexpr size_t SZ_WIN = (size_t)INWP * DM * 2, SZ_WOUT = (size_t)DM * DM * 2, SZ_WUQ = (size_t)UQWP * 768 * 2, SZ_WUKV = (size_t)UKVW * 512 * 2,
                 SZ_WGLU = (size_t)512 * 512 * 2, SZ_W1 = (size_t)DFF * DM * 2, SZ_W2 = (size_t)DM * DFF * 2;
constexpr size_t OFF_WIN = 0, OFF_WOUT = OFF_WIN + SZ_WIN, OFF_WUQ = OFF_WOUT + SZ_WOUT, OFF_WUKV = OFF_WUQ + SZ_WUQ, OFF_WGLU = OFF_WUKV + SZ_WUKV,
                 OFF_W1 = OFF_WGLU + SZ_WGLU, OFF_W2 = OFF_W1 + SZ_W1, WL_STRIDE = OFF_W2 + SZ_W2;
constexpr size_t OFF_MODS = 2 * WL_STRIDE;
constexpr size_t OFF_TSWA = OFF_MODS + (size_t)2 * 5 * 12288 * 4;
constexpr size_t OFF_TMLA = OFF_TSWA + (size_t)2048 * 64 * 8;
constexpr size_t OFF_XS = OFF_TMLA + (size_t)2048 * 32 * 8;
constexpr size_t OFF_H = OFF_XS + (size_t)MT * DM * 4;
constexpr size_t OFF_O = OFF_H + (size_t)MT * DM * 2;
constexpr size_t OFF_R = OFF_O + (size_t)MT * DM * 4;
constexpr size_t OFF_A1 = OFF_R;
constexpr size_t OFF_U = OFF_R;
constexpr size_t OFF_QS = OFF_U + (size_t)MT * 512 * 2;
constexpr size_t OFF_KS = OFF_QS + (size_t)MT * 768 * 2;
constexpr size_t OFF_VTS = OFF_KS + (size_t)NBATCH * 2 * NKEY * 128 * 2;
constexpr size_t OFF_CQ = OFF_VTS + (size_t)NBATCH * 2 * NKEY * 128 * 2;
constexpr size_t OFF_CKV = OFF_CQ + (size_t)MT * 768 * 2;
constexpr size_t OFF_KR = OFF_CKV + (size_t)MT * 512 * 2;
constexpr size_t OFF_RSQ = OFF_KR + (size_t)NBATCH * NKEY * 64 * 2;
constexpr size_t OFF_RSKV = OFF_RSQ + (size_t)MT * 4;
constexpr size_t OFF_YDIR = OFF_RSKV + (size_t)MT * 4;
constexpr size_t OFF_G = OFF_YDIR + (size_t)2 * MT * 512 * 4;
constexpr size_t OFF_QM = OFF_G + (size_t)MT * 512 * 2;
constexpr size_t OFF_KN = OFF_QM + (size_t)MT * UQW * 2;
constexpr size_t OFF_VTM = OFF_KN + (size_t)NBATCH * 6 * NKEY * 128 * 2;
constexpr size_t OFF_MIX = OFF_VTM + (size_t)NBATCH * 6 * NKEY * 128 * 2;
constexpr size_t END_MIXER = OFF_MIX + (size_t)MT * DM * 2;
constexpr size_t END_A1 = OFF_A1 + (size_t)MT * DFF * 2;
constexpr size_t OFF_BAR = ((END_MIXER > END_A1 ? END_MIXER : END_A1) + 255) & ~(size_t)255;
constexpr size_t OFF_OPART = OFF_BAR + 16384;
constexpr size_t WS_END = OFF_OPART + (size_t)8 * MC * DM * 4;

struct Params { const float* in[29]; float* out; unsigned char* ws; };
typedef const Params __attribute__((address_space(4)))* PP;
__device__ __forceinline__ PP kparams() { PP p = (PP)__builtin_amdgcn_kernarg_segment_ptr(); asm volatile("" : "+s"(p)); return p; }

__device__ __forceinline__ unsigned cvt_pk_bf16(float lo, float hi) { unsigned r; asm volatile("v_cvt_pk_bf16_f32 %0, %1, %2" : "=v"(r) : "v"(lo), "v"(hi)); return r; }
__device__ __forceinline__ float bf_lo(unsigned w) { return __uint_as_float(w << 16); }
__device__ __forceinline__ float bf_hi(unsigned w) { return __uint_as_float(w & 0xffff0000u); }
__device__ __forceinline__ float wave_sum(float v) {
#pragma unroll
    for (int o = 1; o < 64; o <<= 1) v += __shfl_xor(v, o);
    return v;
}
#define LDS_WAIT() asm volatile("s_waitcnt lgkmcnt(0)" ::: "memory")
__device__ __forceinline__ unsigned char* lws(unsigned char* p) { asm volatile("" : "+s"(p)); return p; }
__device__ __forceinline__ int obid() { int b = blockIdx.x; asm volatile("" : "+s"(b)); return b; }
__device__ __forceinline__ int otid() { int t = threadIdx.x; asm volatile("" : "+v"(t)); return t; }


#define XB_TMO      128
#define XB_XCNT(j)  (256  + 64 * (j))
#define XB_XSUB(j)  (1280 + 64 * (j))
#define XB_XGEN(j)  (2304 + 64 * (j))
#define XB_TOP      3328
#define XB_TOPGEN   3392
#define XCD_BAR_WORDS 3456
#define XB_SPIN_CAP (1u << 18)
__device__ __forceinline__ unsigned xb_ld(unsigned* p)              { return __hip_atomic_load(p, __ATOMIC_RELAXED, __HIP_MEMORY_SCOPE_AGENT); }
__device__ __forceinline__ unsigned xb_add(unsigned* p, unsigned v) { return __hip_atomic_fetch_add(p, v, __ATOMIC_RELAXED, __HIP_MEMORY_SCOPE_AGENT); }
__device__ __forceinline__ unsigned xb_xcc_id() { return (unsigned)__builtin_amdgcn_s_getreg((3 << 11) | 20) & 0xFu; }
#define XB_SPIN(cond, bar) do { unsigned _sp = 0; while (cond) { __builtin_amdgcn_s_sleep(1); \
    if ((++_sp & 255u) == 0u) { if (xb_ld(&(bar)[XB_TMO])) break; if (_sp > XB_SPIN_CAP) { atomicAdd(&(bar)[XB_TMO], 1u); break; } } } } while (0)
struct XcdBarrier { unsigned* bar; unsigned x; volatile LAS unsigned* st; };
__device__ __forceinline__ XcdBarrier xcd_barrier_post(unsigned* bar, volatile LAS unsigned* st) {
    XcdBarrier b; b.bar = bar; b.x = xb_xcc_id(); b.st = st;
    if (threadIdx.x == 0) (void)xb_add(&bar[XB_XCNT(b.x)], 1u);
    return b;
}
__device__ __forceinline__ void xcd_barrier_complete(unsigned* bar, unsigned x, unsigned& nloc, unsigned& nx) {
    const unsigned G = gridDim.x * gridDim.y * gridDim.z;
    unsigned sum, cnt, mine, sp = 0u;
    for (;;) {
        sum = 0u; cnt = 0u; mine = 0u;
#pragma unroll
        for (unsigned j = 0; j < 16; ++j) { const unsigned c = xb_ld(&bar[XB_XCNT(j)]); sum += c; cnt += (c > 0u) ? 1u : 0u; mine = (j == x) ? c : mine; }
        if (sum == G) break;
        __builtin_amdgcn_s_sleep(1);
        if ((++sp & 255u) == 0u) { if (xb_ld(&bar[XB_TMO])) break; if (sp > XB_SPIN_CAP) { atomicAdd(&bar[XB_TMO], 1u); break; } }
    }
    nloc = mine > 0u ? mine : 1u; nx = cnt > 0u ? cnt : 1u;
}
__device__ __forceinline__ void xcd_barrier(const XcdBarrier& b) {
    asm volatile("s_waitcnt vmcnt(0)" ::: "memory");
    __syncthreads();
    if (threadIdx.x == 0) {
        unsigned* bar = b.bar;
        __builtin_amdgcn_s_waitcnt(0);
        unsigned nloc = b.st[0], nx = b.st[1];
        if (nloc == 0u) { xcd_barrier_complete(bar, b.x, nloc, nx); b.st[0] = nloc; b.st[1] = nx; }
        const unsigned old = xb_add(&bar[XB_XSUB(b.x)], 1u);
        const unsigned gen = old / nloc;
        if (old + 1u == (gen + 1u) * nloc) {
            __builtin_amdgcn_fence(__ATOMIC_RELEASE, "agent");
            asm volatile("s_waitcnt vmcnt(0)" ::: "memory");
            const unsigned og = xb_add(&bar[XB_TOP], 1u);
            const unsigned tg = og / nx;
            if (og + 1u == (tg + 1u) * nx) xb_add(&bar[XB_TOPGEN], 1u);
            else XB_SPIN(xb_ld(&bar[XB_TOPGEN]) == tg, bar);
            __builtin_amdgcn_fence(__ATOMIC_ACQUIRE, "agent");
            xb_add(&bar[XB_XGEN(b.x)], 1u);
            asm volatile("s_waitcnt vmcnt(0)" ::: "memory");
        } else {
            XB_SPIN(xb_ld(&bar[XB_XGEN(b.x)]) == gen, bar);
            __builtin_amdgcn_fence(__ATOMIC_ACQUIRE, "agent");
            asm volatile("s_waitcnt vmcnt(0)" ::: "memory");
        }
    }
    __syncthreads();
}

namespace pg8 {
constexpr int BM = 256, BK = 64, HALF = 128, HTB = HALF * BK * 2, STAGE_BYTES = 8 * HTB, NXCD = 8, WGM = 8;
__host__ __device__ __forceinline__ int lds_byte(int r, int c) { const int st = (r >> 4) * 2 + (c >> 5), rr = r & 15, cc = c & 31, ob = rr * 64 + cc * 2; return st * 1024 + (ob ^ (((ob >> 9) & 1) << 5)); }
__host__ __device__ __forceinline__ void stage_rc(int b, int& R, int& C) { const int st = b / 1024, sb = b % 1024, swz = sb ^ (((sb >> 9) & 1) << 5); R = (st >> 1) * 16 + swz / 64; C = (st & 1) * 32 + (swz % 64) / 2; }
__host__ __device__ __forceinline__ int perm32(int rho) { const int n = rho >> 4, i = rho & 15; return 8 * (i >> 2) + 4 * n + (i & 3); }
struct Unit { int pm, pn, kc; };
struct Gemm { const bf16_t* A; const bf16_t* Bt; int M, N, K, lda, ldb; };
struct StaticOrder {
    int nM, nN, nwg, G, c, tiles;
    __host__ __device__ void init(int M, int N, int G_, int c_, int ksplit = 1) { nM = M / BM; nN = N / BM; tiles = nM * nN; nwg = tiles * ksplit; G = G_; c = c_; }
    __host__ __device__ bool next(int i, Unit& u) const {
        if (c < 0) return false;
        const long L = (long)i * G + c; if (L >= nwg) return false;
        u.kc = (int)L / tiles;
        int wgid = (int)L % tiles; { const int q = tiles / NXCD, r = tiles % NXCD, xcd = wgid % NXCD, off = wgid / NXCD; wgid = (xcd < r ? xcd * (q + 1) : r * (q + 1) + (xcd - r) * q) + off; }
        const int nig = WGM * nN, gid = wgid / nig, fm = gid * WGM, gsz = (nM - fm) < WGM ? (nM - fm) : WGM;
        u.pm = fm + ((wgid % nig) % gsz); u.pn = (wgid % nig) / gsz; return true;
    }
};
template <class Epi>
__device__ __forceinline__ void gemm_phase(LAS unsigned char* lds, const Gemm g, const StaticOrder& S, const Epi& E) {
    const int tid = otid(), wid = __builtin_amdgcn_readfirstlane(tid >> 6), lane = tid & 63, wr = wid >> 2, wc = wid & 3, fr = lane & 15, fq = lane >> 4;
    const int K = g.K, nt = K / BK;
    unsigned voffA, voffB;
    { int R, C; stage_rc(tid * 16, R, C); const int Rb = Epi::PERM ? ((R & ~31) + perm32(R & 31)) : R;
      voffA = (unsigned)(R * g.lda + C) * 2u; voffB = (unsigned)(Rb * g.ldb + C) * 2u; }
    const size_t r64voffA = (size_t)64 * g.lda * 2, r64voffB = (size_t)64 * g.ldb * 2;
    const size_t kstep = (size_t)(BK * 2);
    const size_t hstepA = (size_t)HALF * g.lda * 2, hstepB = (size_t)HALF * g.ldb * 2;
    const size_t tstepA = 2 * hstepA, tstepB = 2 * hstepB, cstep = (size_t)K * 2;
    const unsigned ldsw = (unsigned)wid * 1024u;
    const int aoff = lds_byte(wr * 64 + fr, fq * 8), boff = lds_byte(wc * 32 + fr, fq * 8);
#define PG8_SA(b, h) (((b) * 2 + (h)) * HTB)
#define PG8_SB(b, h) ((4 + (b) * 2 + (h)) * HTB)
#define PG8_STAGE(bufoff, gbase, voff) do { _Pragma("unroll") for (int _i = 0; _i < 2; ++_i) \
        __builtin_amdgcn_global_load_lds((const unsigned*)((const char*)(gbase) + _i * r64##voff + (voff)), (LAS unsigned*)(lds + (bufoff) + ldsw + _i * 8192), 16, 0, 0); } while (0)
#define PG8_LDA(dst, b, h) do { _Pragma("unroll") for (int m = 0; m < 4; ++m) _Pragma("unroll") for (int k = 0; k < 2; ++k) dst[m][k] = *(const LAS bf16x8*)(lds + PG8_SA(b, h) + aoff + m * 2048 + k * 1024); } while (0)
#define PG8_LDB(dst, b, h) do { _Pragma("unroll") for (int n = 0; n < 2; ++n) _Pragma("unroll") for (int k = 0; k < 2; ++k) dst[n][k] = *(const LAS bf16x8*)(lds + PG8_SB(b, h) + boff + n * 2048 + k * 1024); } while (0)
#define PG8_MMA(ai, bj, At, Bt) do { __builtin_amdgcn_s_setprio(1); _Pragma("unroll") for (int m = 0; m < 4; ++m) _Pragma("unroll") for (int n = 0; n < 2; ++n) _Pragma("unroll") for (int k = 0; k < 2; ++k) \
        acc[ai][bj][m][n] = __builtin_amdgcn_mfma_f32_16x16x32_bf16(Bt[n][k], At[m][k], acc[ai][bj][m][n], 0, 0, 0); __builtin_amdgcn_s_setprio(0); } while (0)
#define PG8_WAIT_V(n) asm volatile("s_waitcnt vmcnt(" #n ")" ::: "memory")
#define PG8_WAIT_L(n) asm volatile("s_waitcnt lgkmcnt(" #n ")" ::: "memory")
#define PG8_BAR __builtin_amdgcn_s_barrier()
#define PG8_SCHED __builtin_amdgcn_sched_barrier(0)
    Unit cur, nxt; int ui = 0;
    if (!S.next(0, cur)) return;
    f32x4 acc[2][2][4][2];
#pragma unroll
    for (int a = 0; a < 2; ++a)
#pragma unroll
        for (int b = 0; b < 2; ++b)
#pragma unroll
            for (int m = 0; m < 4; ++m)
#pragma unroll
                for (int n = 0; n < 2; ++n) acc[a][b][m][n] = (f32x4){0.f, 0.f, 0.f, 0.f};
    bf16x8 At[4][2], B0[2][2], B1[2][2];
    const char* cA = (const char*)g.A + (size_t)cur.pm * tstepA + (size_t)cur.kc * cstep; const char* cB = (const char*)g.Bt + (size_t)cur.pn * tstepB + (size_t)cur.kc * cstep;
    PG8_STAGE(PG8_SB(0, 0), cB, voffB); PG8_STAGE(PG8_SB(0, 1), cB + hstepB, voffB); PG8_STAGE(PG8_SA(0, 0), cA, voffA); PG8_STAGE(PG8_SA(0, 1), cA + hstepA, voffA);
    if (wr == 1) PG8_BAR;
    PG8_WAIT_V(2); PG8_BAR;
    PG8_STAGE(PG8_SB(1, 0), cB + kstep, voffB); PG8_STAGE(PG8_SA(1, 0), cA + kstep, voffA); PG8_STAGE(PG8_SB(1, 1), cB + hstepB + kstep, voffB);
    PG8_WAIT_V(6); PG8_BAR;
    for (;;) {
        const bool has_next = S.next(ui + 1, nxt);
        const char* nA = has_next ? (const char*)g.A + (size_t)nxt.pm * tstepA + (size_t)nxt.kc * cstep : cA; const char* nB = has_next ? (const char*)g.Bt + (size_t)nxt.pn * tstepB + (size_t)nxt.kc * cstep : cB;
        for (int t = 0; t < nt; t += 2) {
            const bool last = (t == nt - 2);
            const char* a1 = cA + (size_t)(t + 1) * kstep;
            const char* a2 = last ? nA : cA + (size_t)(t + 2) * kstep; const char* b2 = last ? nB : cB + (size_t)(t + 2) * kstep;
            const char* a3 = a2 + kstep; const char* b3 = b2 + kstep;
            PG8_LDB(B0, 0, 0); PG8_LDB(B1, 0, 1); PG8_SCHED; PG8_LDA(At, 0, 0); PG8_STAGE(PG8_SA(1, 1), a1 + hstepA, voffA);
            PG8_WAIT_V(8); PG8_WAIT_L(0); PG8_BAR; PG8_MMA(0, 0, At, B0); PG8_MMA(0, 1, At, B1); PG8_BAR; PG8_SCHED;
            PG8_LDA(At, 0, 1); PG8_STAGE(PG8_SB(0, 0), b2, voffB); PG8_STAGE(PG8_SB(0, 1), b2 + hstepB, voffB); PG8_STAGE(PG8_SA(0, 0), a2, voffA);
            PG8_WAIT_V(8); PG8_WAIT_L(0); PG8_BAR; PG8_MMA(1, 0, At, B0); PG8_MMA(1, 1, At, B1); PG8_BAR; PG8_SCHED;
            PG8_LDB(B0, 1, 0); PG8_LDB(B1, 1, 1); PG8_SCHED; PG8_LDA(At, 1, 0); PG8_STAGE(PG8_SA(0, 1), a2 + hstepA, voffA);
            PG8_WAIT_V(8); PG8_WAIT_L(0); PG8_BAR; PG8_MMA(0, 0, At, B0); PG8_MMA(0, 1, At, B1); PG8_BAR; PG8_SCHED;
            PG8_LDA(At, 1, 1); PG8_STAGE(PG8_SB(1, 0), b3, voffB); PG8_STAGE(PG8_SB(1, 1), b3 + hstepB, voffB); PG8_STAGE(PG8_SA(1, 0), a3, voffA);
            PG8_WAIT_V(8); PG8_WAIT_L(0); PG8_BAR; PG8_MMA(1, 0, At, B0); PG8_MMA(1, 1, At, B1); PG8_BAR; PG8_SCHED;
        }
        if (wr == 0) PG8_BAR;
        E(acc, cur, wr, wc, fr, fq);
        if (!has_next) break;
#pragma unroll
        for (int a = 0; a < 2; ++a)
#pragma unroll
            for (int b = 0; b < 2; ++b)
#pragma unroll
                for (int m = 0; m < 4; ++m)
#pragma unroll
                    for (int n = 0; n < 2; ++n) acc[a][b][m][n] = (f32x4){0.f, 0.f, 0.f, 0.f};
        cur = nxt; cA = nA; cB = nB; ++ui;
        if (wr == 1) PG8_BAR;
    }
    PG8_WAIT_V(0);
    PG8_BAR;
#undef PG8_SA
#undef PG8_SB
#undef PG8_STAGE
#undef PG8_LDA
#undef PG8_LDB
#undef PG8_MMA
#undef PG8_WAIT_V
#undef PG8_WAIT_L
#undef PG8_BAR
#undef PG8_SCHED
}
}
using pg8::Unit; using pg8::Gemm; using pg8::StaticOrder;

__device__ __forceinline__ void rope8(f32x4& v0, f32x4& v1, const float* tab) {
    const f32x4 t0 = *(const f32x4*)tab, t1 = *(const f32x4*)(tab + 4);
    float a, b;
    a = v0.x * t0.x - v0.y * t0.y; b = v0.y * t0.x + v0.x * t0.y; v0.x = a; v0.y = b;
    a = v0.z * t0.z - v0.w * t0.w; b = v0.w * t0.z + v0.z * t0.w; v0.z = a; v0.w = b;
    a = v1.x * t1.x - v1.y * t1.y; b = v1.y * t1.x + v1.x * t1.y; v1.x = a; v1.y = b;
    a = v1.z * t1.z - v1.w * t1.w; b = v1.w * t1.z + v1.z * t1.w; v1.z = a; v1.w = b;
}
__device__ __forceinline__ u32x4 pack8(const f32x4 v0, const f32x4 v1) {
    u32x4 w; w.x = cvt_pk_bf16(v0.x, v0.y); w.y = cvt_pk_bf16(v0.z, v0.w); w.z = cvt_pk_bf16(v1.x, v1.y); w.w = cvt_pk_bf16(v1.z, v1.w); return w;
}
__device__ __forceinline__ void row_decode(int row, bool& lat, int& b, int& t, int& keyidx) {
    lat = row < ML;
    if (lat) { b = row >> 11; t = row & 2047; keyidx = CTXL + t; } else { const int r2 = row - ML; b = r2 >> 8; t = r2 & 255; keyidx = t; }
}
__device__ __forceinline__ void store_vt8(bf16_t* vt, int d0, int keyidx, const u32x4 w) {
    const int kp = (keyidx & ~31) | (((keyidx >> 2) & 3) << 3) | (((keyidx >> 4) & 1) << 2) | (keyidx & 3);
    bf16_t* p = vt + (size_t)d0 * NKEY + kp;
    p[0] = (bf16_t)(w.x & 0xffff); p[NKEY] = (bf16_t)(w.x >> 16); p[2 * NKEY] = (bf16_t)(w.y & 0xffff); p[3 * NKEY] = (bf16_t)(w.y >> 16);
    p[4 * NKEY] = (bf16_t)(w.z & 0xffff); p[5 * NKEY] = (bf16_t)(w.z >> 16); p[6 * NKEY] = (bf16_t)(w.w & 0xffff); p[7 * NKEY] = (bf16_t)(w.w >> 16);
}

struct EpiInProj {
    static constexpr bool PERM = true;
    unsigned char* wsb;
    __device__ __forceinline__ void operator()(const f32x4 (&acc)[2][2][4][2], const Unit& u, int wr, int wc, int fr, int fq) const {
        const int pn = u.pn, cw = wc * 32 + fq * 8;
        bf16_t* const U = (bf16_t*)(wsb + OFF_U); bf16_t* const QS = (bf16_t*)(wsb + OFF_QS); bf16_t* const KS = (bf16_t*)(wsb + OFF_KS); bf16_t* const VTS = (bf16_t*)(wsb + OFF_VTS);
        bf16_t* const CQ = (bf16_t*)(wsb + OFF_CQ); bf16_t* const CKV = (bf16_t*)(wsb + OFF_CKV); bf16_t* const KR = (bf16_t*)(wsb + OFF_KR);
        const float* const tswa = (const float*)(wsb + OFF_TSWA); const float* const tmla = (const float*)(wsb + OFF_TMLA);
#pragma unroll
        for (int ai = 0; ai < 2; ++ai)
#pragma unroll
            for (int m = 0; m < 4; ++m) {
                const int row = u.pm * 256 + ai * 128 + wr * 64 + m * 16 + fr;
                bool lat; int b, t, keyidx; row_decode(row, lat, b, t, keyidx);
#pragma unroll
                for (int bj = 0; bj < 2; ++bj) {
                    f32x4 v0 = acc[ai][bj][m][0], v1 = acc[ai][bj][m][1];
                    const int cl = bj * 128 + cw;
                    if (pn < 2) { const int cu = pn * 256 + cl; *(u32x4*)(U + (((size_t)(b * 32 + (cu >> 4)) * NKEY + keyidx) << 4) + (cu & 15)) = pack8(v0, v1); }
                    else if (pn < 5) { if (lat) rope8(v0, v1, tswa + ((size_t)t * 64 + (cw >> 1)) * 2); *(u32x4*)(QS + (size_t)row * 768 + (pn - 2) * 256 + cl) = pack8(v0, v1); }
                    else if (pn == 5) { if (lat) rope8(v0, v1, tswa + ((size_t)t * 64 + (cw >> 1)) * 2); *(u32x4*)(KS + ((size_t)(b * 2 + bj) * NKEY + keyidx) * 128 + cw) = pack8(v0, v1); }
                    else if (pn == 6) { store_vt8(VTS + (size_t)(b * 2 + bj) * 128 * NKEY, cw, keyidx, pack8(v0, v1)); }
                    else if (pn < 10) { *(u32x4*)(CQ + (size_t)row * 768 + (pn - 7) * 256 + cl) = pack8(v0, v1); }
                    else if (pn < 12) { *(u32x4*)(CKV + (size_t)row * 512 + (pn - 10) * 256 + cl) = pack8(v0, v1); }
                    else { if (bj == 0 && wc < 2) { if (lat) rope8(v0, v1, tmla + ((size_t)t * 32 + (cw >> 1)) * 2); *(u32x4*)(KR + ((size_t)b * NKEY + keyidx) * 64 + cw) = pack8(v0, v1); } }
                }
            }
    }
};
struct EpiUQ {
    static constexpr bool PERM = true;
    bf16_t* QM; const float *rs, *tmla;
    __device__ __forceinline__ void operator()(const f32x4 (&acc)[2][2][4][2], const Unit& u, int wr, int wc, int fr, int fq) const {
#pragma unroll
        for (int ai = 0; ai < 2; ++ai)
#pragma unroll
            for (int m = 0; m < 4; ++m) {
                const int row = u.pm * 256 + ai * 128 + wr * 64 + m * 16 + fr;
                const float r = rs[row]; const bool lat = row < ML; const int t = row & 2047;
#pragma unroll
                for (int bj = 0; bj < 2; ++bj) {
                    const int col = u.pn * 256 + bj * 128 + wc * 32 + fq * 8;
                    if (col < UQW) {
                        f32x4 v0 = acc[ai][bj][m][0] * r, v1 = acc[ai][bj][m][1] * r;
                        if (col >= 768 && lat) rope8(v0, v1, tmla + ((size_t)t * 32 + (((col - 768) & 63) >> 1)) * 2);
                        *(u32x4*)(QM + (size_t)row * UQW + col) = pack8(v0, v1);
                    }
                }
            }
    }
};
struct EpiUKV {
    static constexpr bool PERM = true;
    bf16_t *KN, *VTM; const float* rs;
    __device__ __forceinline__ void operator()(const f32x4 (&acc)[2][2][4][2], const Unit& u, int wr, int wc, int fr, int fq) const {
        const int h = u.pn, cw = wc * 32 + fq * 8;
#pragma unroll
        for (int ai = 0; ai < 2; ++ai)
#pragma unroll
            for (int m = 0; m < 4; ++m) {
                const int row = u.pm * 256 + ai * 128 + wr * 64 + m * 16 + fr;
                bool lat; int b, t, keyidx; row_decode(row, lat, b, t, keyidx);
                const float r = rs[row];
                *(u32x4*)(KN + ((size_t)(b * 6 + h) * NKEY + keyidx) * 128 + cw) = pack8(acc[ai][0][m][0] * r, acc[ai][0][m][1] * r);
                store_vt8(VTM + (size_t)(b * 6 + h) * 128 * NKEY, cw, keyidx, pack8(acc[ai][1][m][0] * r, acc[ai][1][m][1] * r));
            }
    }
};
struct EpiGLU {
    static constexpr bool PERM = true;
    const bf16_t* G; const float* bias; bf16_t* MIX;
    __device__ __forceinline__ void operator()(const f32x4 (&acc)[2][2][4][2], const Unit& u, int wr, int wc, int fr, int fq) const {
#pragma unroll
        for (int bj = 0; bj < 2; ++bj) {
            const int col = u.pn * 256 + bj * 128 + wc * 32 + fq * 8;
            const f32x4 b0 = *(const f32x4*)(bias + col), b1 = *(const f32x4*)(bias + col + 4);
#pragma unroll
            for (int ai = 0; ai < 2; ++ai)
#pragma unroll
                for (int m = 0; m < 4; ++m) {
                    const int row = u.pm * 256 + ai * 128 + wr * 64 + m * 16 + fr;
                    const u32x4 gw = *(const u32x4*)(G + (size_t)row * 512 + col);
                    const f32x4 z0 = acc[ai][bj][m][0] + b0, z1 = acc[ai][bj][m][1] + b1;
                    f32x4 o0, o1;
                    o0.x = bf_lo(gw.x) / (1.f + __expf(-z0.x)); o0.y = bf_hi(gw.x) / (1.f + __expf(-z0.y)); o0.z = bf_lo(gw.y) / (1.f + __expf(-z0.z)); o0.w = bf_hi(gw.y) / (1.f + __expf(-z0.w));
                    o1.x = bf_lo(gw.z) / (1.f + __expf(-z1.x)); o1.y = bf_hi(gw.z) / (1.f + __expf(-z1.y)); o1.z = bf_lo(gw.w) / (1.f + __expf(-z1.z)); o1.w = bf_hi(gw.w) / (1.f + __expf(-z1.w));
                    *(u32x4*)(MIX + (size_t)row * DM + col) = pack8(o0, o1);
                }
        }
    }
};
struct EpiBf16Out {
    static constexpr bool PERM = true;
    bf16_t* C; int ldc; size_t kc_stride;
    __device__ __forceinline__ void operator()(const f32x4 (&acc)[2][2][4][2], const Unit& u, int wr, int wc, int fr, int fq) const {
        const int row0 = u.pm * 256 + wr * 64 + fr, col0 = u.pn * 256 + wc * 32 + 8 * fq;
#pragma unroll
        for (int ai = 0; ai < 2; ++ai)
#pragma unroll
            for (int m = 0; m < 4; ++m) { bf16_t* rowp = C + (size_t)u.kc * kc_stride + (size_t)(row0 + ai * 128 + m * 16) * ldc + col0;
#pragma unroll
                for (int bj = 0; bj < 2; ++bj) *(u32x4*)(rowp + bj * 128) = pack8(acc[ai][bj][m][0], acc[ai][bj][m][1]); }
    }
};
struct EpiSqRelu {
    static constexpr bool PERM = true;
    bf16_t* O; int ldc;
    __device__ __forceinline__ void operator()(const f32x4 (&acc)[2][2][4][2], const Unit& u, int wr, int wc, int fr, int fq) const {
        const int row0 = u.pm * 256 + wr * 64 + fr, col0 = u.pn * 256 + wc * 32 + 8 * fq;
#pragma unroll
        for (int ai = 0; ai < 2; ++ai)
#pragma unroll
            for (int m = 0; m < 4; ++m) { bf16_t* rowp = O + (size_t)(row0 + ai * 128 + m * 16) * ldc + col0;
#pragma unroll
                for (int bj = 0; bj < 2; ++bj) {
                    f32x4 v0 = acc[ai][bj][m][0], v1 = acc[ai][bj][m][1];
#pragma unroll
                    for (int j = 0; j < 4; ++j) { const float a = fmaxf(v0[j], 0.f), b = fmaxf(v1[j], 0.f); v0[j] = a * a; v1[j] = b * b; }
                    *(u32x4*)(rowp + bj * 128) = pack8(v0, v1); } }
    }
};

__device__ __forceinline__ int src_col(int mode, int n) {
    if (mode == 1) {
        if (n >= 512 && n < 1536) { const int base = n & ~127, c = n & 127, half = c >> 6, cc = c & 63; return base + half * 64 + (cc >> 1) + 32 * (cc & 1); }
        if (n >= 3072) { const int c = n - 3072, half = c >> 5, cc = c & 31; return 3072 + half * 32 + (cc >> 1) + 16 * (cc & 1); }
        return n;
    }
    if (mode == 2) {
        if (n < 768) return (n >> 7) * 192 + (n & 127);
        const int r = n - 768, h = r >> 6, p = r & 63, half = p >> 5, cc = p & 31; return h * 192 + 128 + half * 32 + (cc >> 1) + 16 * (cc & 1);
    }
    return n;
}
__device__ __forceinline__ void transpose_item(const float* W, int K, int N, int nblk, bf16_t* WT, int mode, const float* kscale, LAS float* scr, int item, int lane) {
    const int kb = item / nblk, nb = item % nblk, k0 = 64 * kb, n0 = 32 * nb;
    const int sc = src_col(mode, n0 + (lane & 31));
    float wv[32];
#pragma unroll
    for (int i = 0; i < 32; ++i) wv[i] = W[(size_t)(k0 + 2 * i + (lane >> 5)) * N + sc];
    if (kscale) {
#pragma unroll
        for (int i = 0; i < 32; ++i) wv[i] *= kscale[k0 + 2 * i + (lane >> 5)];
    }
#pragma unroll
    for (int i = 0; i < 32; ++i) scr[(2 * i + (lane >> 5)) * 33 + (lane & 31)] = wv[i];
    LDS_WAIT();
    const int c = lane & 7;
#pragma unroll
    for (int j = 0; j < 4; ++j) { const int n = (lane >> 3) + 8 * j; const LAS float* s = scr + (8 * c) * 33 + n;
        u32x4 o; o.x = cvt_pk_bf16(s[0 * 33], s[1 * 33]); o.y = cvt_pk_bf16(s[2 * 33], s[3 * 33]); o.z = cvt_pk_bf16(s[4 * 33], s[5 * 33]); o.w = cvt_pk_bf16(s[6 * 33], s[7 * 33]);
        *(u32x4*)(WT + (size_t)(n0 + n) * K + k0 + 8 * c) = o; }
    LDS_WAIT();
}
__device__ __forceinline__ void ada_item(PP P, LAS unsigned char* lds, int item) {
    const int tid = otid(), layer = item / 96, col0 = (item % 96) * 128;
    LAS float* sv = (LAS float*)lds;
    LAS float* part = sv + 5 * 2048;
    for (int i = tid; i < 5 * 2048; i += 512) { const int v = i >> 11, k = i & 2047; const float c = v < 4 ? P->in[1][v * 2048 + k] : P->in[3][k]; sv[i] = c / (1.f + expf(-c)); }
    __syncthreads();
    const int cgp = tid & 31, ks = tid >> 5;
    float acc[5][4];
#pragma unroll
    for (int v = 0; v < 5; ++v)
#pragma unroll
        for (int j = 0; j < 4; ++j) acc[v][j] = 0.f;
    const float* wp = P->in[4] + (size_t)layer * 2048 * 12288 + (size_t)(ks * 128) * 12288 + col0 + 4 * cgp;
#pragma unroll 8
    for (int k = 0; k < 128; ++k) {
        const f32x4 w = *(const f32x4*)(wp + (size_t)k * 12288);
#pragma unroll
        for (int v = 0; v < 5; ++v) { const float s = sv[v * 2048 + ks * 128 + k]; acc[v][0] += s * w.x; acc[v][1] += s * w.y; acc[v][2] += s * w.z; acc[v][3] += s * w.w; }
    }
#pragma unroll
    for (int v = 0; v < 5; ++v)
#pragma unroll
        for (int j = 0; j < 4; ++j) part[(ks * 5 + v) * 128 + 4 * cgp + j] = acc[v][j];
    __syncthreads();
    float* mods = (float*)(lws(P->ws) + OFF_MODS);
    for (int o = tid; o < 640; o += 512) { const int v = o >> 7, cc = o & 127; float s = P->in[5][layer * 12288 + col0 + cc];
#pragma unroll
        for (int q = 0; q < 16; ++q) s += part[(q * 5 + v) * 128 + cc];
        mods[(size_t)(layer * 5 + v) * 12288 + col0 + cc] = s; }
    __syncthreads();
}
__device__ __forceinline__ void phase_prep(PP P, LAS unsigned char* lds, int G) {
    const int tid = otid(), wid = tid >> 6, lane = tid & 63, bid = obid();
    for (int it = bid; it < 192; it += G) ada_item(P, lds, it);
    { float* tswa = (float*)(lws(P->ws) + OFF_TSWA); float* tmla = (float*)(lws(P->ws) + OFF_TMLA);
      for (int i = bid * 512 + tid; i < 2048 * 64; i += G * 512) { const int t = i >> 6, pi = i & 63, j = pi & 31; const float inv = exp2f(-(float)j * (13.287712379549449f / 32.f));
          const float ang = (float)(pi < 32 ? (t >> 6) : (t & 63)) * inv; tswa[2 * i] = cosf(ang); tswa[2 * i + 1] = sinf(ang); }
      for (int i = bid * 512 + tid; i < 2048 * 32; i += G * 512) { const int t = i >> 5, pi = i & 31, j = pi & 15; const float inv = exp2f(-(float)j * (13.287712379549449f / 16.f));
          const float ang = (float)(pi < 16 ? (t >> 6) : (t & 63)) * inv; tmla[2 * i] = cosf(ang); tmla[2 * i + 1] = sinf(ang); } }
    LAS float* scr = (LAS float*)(lds + wid * 8704);
    const int gw = bid * NWAVES + wid, NGW = G * NWAVES;
    constexpr int I_IN = 32 * 98, I_OUT = 32 * 64, I_UQ = 12 * 36, I_UKV = 8 * 48, I_GLU = 8 * 16, I_1 = 32 * 256, I_2 = 128 * 64;
    constexpr int I_L = I_IN + I_OUT + I_UQ + I_UKV + I_GLU + I_1 + I_2;
    auto do_item = [&](int it) {
        const int layer = it / I_L; int r = it % I_L;
        unsigned char* wl = lws(P->ws) + (size_t)layer * WL_STRIDE;
        if (r < I_IN) { transpose_item(P->in[10] + (size_t)layer * DM * INW, DM, INW, 98, (bf16_t*)(wl + OFF_WIN), 1, nullptr, scr, r, lane); return; } r -= I_IN;
        if (r < I_OUT) { transpose_item(P->in[11] + (size_t)layer * DM * DM, DM, DM, 64, (bf16_t*)(wl + OFF_WOUT), 0, nullptr, scr, r, lane); return; } r -= I_OUT;
        if (r < I_UQ) { transpose_item(P->in[24] + (size_t)layer * 768 * UQW, 768, UQW, 36, (bf16_t*)(wl + OFF_WUQ), 2, P->in[23] + layer * 768, scr, r, lane); return; } r -= I_UQ;
        if (r < I_UKV) { transpose_item(P->in[26] + (size_t)layer * 512 * UKVW, 512, UKVW, 48, (bf16_t*)(wl + OFF_WUKV), 0, P->in[25] + layer * 512, scr, r, lane); return; } r -= I_UKV;
        if (r < I_GLU) { transpose_item(P->in[20] + (size_t)layer * 512 * 512, 512, 512, 16, (bf16_t*)(wl + OFF_WGLU), 0, nullptr, scr, r, lane); return; } r -= I_GLU;
        if (r < I_1) { transpose_item(P->in[27] + (size_t)layer * DM * DFF, DM, DFF, 256, (bf16_t*)(wl + OFF_W1), 0, nullptr, scr, r, lane); return; } r -= I_1;
        transpose_item(P->in[28] + (size_t)layer * DFF * DM, DFF, DM, 64, (bf16_t*)(wl + OFF_W2), 0, nullptr, scr, r, lane);
    };
    if (G == 256) {
        const int kmax = bid < 192 ? 18 : 22;
        for (int k = 0; k < kmax; ++k) { const int it = gw + k * NGW; if (it < 2 * I_L) do_item(it); }
        if (bid >= 192) { const int w2 = gw - 1536;
            for (int m = 0; m < 12; ++m) { const int j = w2 + m * 512, it = (j % 1536) + (18 + j / 1536) * NGW; if (it < 2 * I_L) do_item(it); } }
    } else {
        for (int it = gw; it < 2 * I_L; it += NGW) do_item(it);
    }
}

struct RowArgs { const void* xin; bool xin_bf; void* xout; bool xout_bf; const bf16_t* o; int nparts; const float* gate; const float* gpost; const float* gpre; const float* shift; const float* scale; bf16_t* hout; };
struct RowParams { f32x4 gg[8], ga[8], sh[8]; };
__device__ __forceinline__ void row_params(const RowArgs& a, int lane, RowParams& p) {
#pragma unroll
    for (int j = 0; j < 8; ++j) { const int d = 4 * (lane + 64 * j);
        if (a.o) p.gg[j] = *(const f32x4*)(a.gate + d) * *(const f32x4*)(a.gpost + d);
        if (a.hout) { p.ga[j] = *(const f32x4*)(a.gpre + d) * (*(const f32x4*)(a.scale + d) + 1.f); p.sh[j] = *(const f32x4*)(a.shift + d); } }
}
template <int NR, bool SH>
__device__ __forceinline__ void row_stage(const RowArgs (&A)[NR], int lane, const RowParams& PR) {
    f32x4 v[NR][8], ov[NR][8];
#pragma unroll
    for (int r = 0; r < NR; ++r)
#pragma unroll
        for (int j = 0; j < 8; ++j) {
            if (A[r].xin_bf) { const u32x2 w = *(const u32x2*)((const bf16_t*)A[r].xin + 4 * (lane + 64 * j)); v[r][j] = (f32x4){bf_lo(w.x), bf_hi(w.x), bf_lo(w.y), bf_hi(w.y)}; }
            else v[r][j] = *(const f32x4*)((const float*)A[r].xin + 4 * (lane + 64 * j)); }
    if (A[0].o) {
#pragma unroll
        for (int r = 0; r < NR; ++r) {
#pragma unroll
            for (int j = 0; j < 8; ++j) { const u32x2 w = *(const u32x2*)(A[r].o + 4 * (lane + 64 * j)); ov[r][j] = (f32x4){bf_lo(w.x), bf_hi(w.x), bf_lo(w.y), bf_hi(w.y)}; }
            if (A[r].nparts == 8) {
#pragma unroll
                for (int j = 0; j < 8; ++j) { u32x2 w2[7];
#pragma unroll
                    for (int pp = 0; pp < 7; ++pp) w2[pp] = *(const u32x2*)(A[r].o + (size_t)(pp + 1) * MC * DM + 4 * (lane + 64 * j));
#pragma unroll
                    for (int pp = 0; pp < 7; ++pp) ov[r][j] += (f32x4){bf_lo(w2[pp].x), bf_hi(w2[pp].x), bf_lo(w2[pp].y), bf_hi(w2[pp].y)}; }
            }
        }
        float rstd[NR];
#pragma unroll
        for (int r = 0; r < NR; ++r) { float ss = 0.f;
#pragma unroll
            for (int j = 0; j < 8; ++j) ss += ov[r][j].x * ov[r][j].x + ov[r][j].y * ov[r][j].y + ov[r][j].z * ov[r][j].z + ov[r][j].w * ov[r][j].w;
            rstd[r] = rsqrtf(wave_sum(ss) * (1.f / DM) + EPSN); }
#pragma unroll
        for (int j = 0; j < 8; ++j) {
            f32x4 gg[NR];
#pragma unroll
            for (int r = 0; r < NR; ++r) if (!SH) gg[r] = *(const f32x4*)(A[r].gate + 4 * (lane + 64 * j)) * *(const f32x4*)(A[r].gpost + 4 * (lane + 64 * j));
#pragma unroll
            for (int r = 0; r < NR; ++r) v[r][j] += (SH ? PR.gg[j] : gg[r]) * (ov[r][j] * rstd[r]);
        }
    }
    if (A[0].xout) {
#pragma unroll
        for (int r = 0; r < NR; ++r)
#pragma unroll
            for (int j = 0; j < 8; ++j) {
                if (A[r].xout_bf) { u32x2 w; w.x = cvt_pk_bf16(v[r][j].x, v[r][j].y); w.y = cvt_pk_bf16(v[r][j].z, v[r][j].w); *(u32x2*)((bf16_t*)A[r].xout + 4 * (lane + 64 * j)) = w; }
                else *(f32x4*)((float*)A[r].xout + 4 * (lane + 64 * j)) = v[r][j]; }
    }
    if (A[0].hout) {
        float rstd[NR];
#pragma unroll
        for (int r = 0; r < NR; ++r) { float ss = 0.f;
#pragma unroll
            for (int j = 0; j < 8; ++j) ss += v[r][j].x * v[r][j].x + v[r][j].y * v[r][j].y + v[r][j].z * v[r][j].z + v[r][j].w * v[r][j].w;
            rstd[r] = rsqrtf(wave_sum(ss) * (1.f / DM) + EPSN); }
#pragma unroll
        for (int j = 0; j < 8; ++j) { const int d = 4 * (lane + 64 * j);
            f32x4 ga[NR], sh[NR];
#pragma unroll
            for (int r = 0; r < NR; ++r) if (!SH) { ga[r] = *(const f32x4*)(A[r].gpre + d) * (*(const f32x4*)(A[r].scale + d) + 1.f); sh[r] = *(const f32x4*)(A[r].shift + d); }
#pragma unroll
            for (int r = 0; r < NR; ++r) { const f32x4 h = v[r][j] * rstd[r] * (SH ? PR.ga[j] : ga[r]) + (SH ? PR.sh[j] : sh[r]);
                u32x2 w; w.x = cvt_pk_bf16(h.x, h.y); w.y = cvt_pk_bf16(h.z, h.w); *(u32x2*)(A[r].hout + d) = w; }
        }
    }
}
__device__ __forceinline__ RowArgs row_args(PP P, int stage, int layer, int row) {
    const float* mods = (const float*)(lws(P->ws) + OFF_MODS);
    bf16_t* XS = (bf16_t*)(lws(P->ws) + OFF_XS); bf16_t* H = (bf16_t*)(lws(P->ws) + OFF_H); const bf16_t* O = (const bf16_t*)(lws(P->ws) + OFF_O); const bf16_t* OP = (const bf16_t*)(lws(P->ws) + OFF_OPART);
    const int v = row < ML ? (row >> 11) : 4;
    const float* xorig = row < ML ? P->in[0] + (size_t)row * DM : P->in[2] + (size_t)(row - ML) * DM;
    const float* md = mods + (size_t)(layer * 5 + v) * 12288;
    const bf16_t* orow = row < ML ? O + (size_t)row * DM : OP + (size_t)(row - ML) * DM; const int np = row < ML ? 1 : 8;
    RowArgs a;
    bf16_t* xs = XS + (size_t)row * DM; bf16_t* hrow = H + (size_t)row * DM;
    if (stage == 0) a = RowArgs{xorig, false, nullptr, false, nullptr, 1, nullptr, nullptr, P->in[6], md, md + DM, hrow};
    else if (stage == 1) { if (layer == 0) a = RowArgs{xorig, false, xs, true, orow, np, md + 2 * DM, P->in[7], P->in[8], md + 3 * DM, md + 4 * DM, hrow};
                           else a = RowArgs{xs, true, xs, true, orow, np, md + 2 * DM, P->in[7] + DM, P->in[8] + DM, md + 3 * DM, md + 4 * DM, hrow}; }
    else if (layer == 0) { const float* md1 = mods + (size_t)(5 + v) * 12288;
        a = RowArgs{xs, true, xs, true, orow, np, md + 5 * DM, P->in[9], P->in[6] + DM, md1, md1 + DM, hrow}; }
    else a = RowArgs{xs, true, P->out + (size_t)row * DM, false, orow, np, md + 5 * DM, P->in[9] + DM, nullptr, nullptr, nullptr, nullptr};
    return a;
}
__device__ __forceinline__ void phase_rows(PP P, int stage, int layer, int G) {
    const int tid = otid(), wid = tid >> 6, lane = tid & 63;
    const int NW = G * NWAVES, gw = obid() * NWAVES + wid;
#pragma unroll 1
    for (int row0 = 4 * gw; row0 < ML; row0 += 4 * NW) {
        RowParams PR; row_params(row_args(P, stage, layer, row0), lane, PR);
#pragma unroll 1
        for (int row = row0; row < row0 + 4; ++row) { const RowArgs A[1] = {row_args(P, stage, layer, row)}; row_stage<1, true>(A, lane, PR); } }
    if (stage == 0 || layer == 0) {
#pragma unroll 1
        for (int row = ML + gw; row < MT; row += NW) { const RowArgs A[1] = {row_args(P, stage, layer, row)}; RowParams PR; row_stage<1, false>(A, lane, PR); }
    }
}

__device__ __forceinline__ int s5_row(int b, int dir, int s) {
    if (dir == 0) return s < CTXL ? ML + b * CTXL + s : b * SEQ + (s - CTXL);
    return s < CTXL ? ML + b * CTXL + (CTXL - 1 - s) : b * SEQ + (SEQ - 1 - (s - CTXL));
}
__device__ __forceinline__ int s5_key(int dir, int s) { return dir == 0 ? s : (s < CTXL ? CTXL - 1 - s : CTXL + SEQ - 1 - (s - CTXL)); }
__device__ __forceinline__ void s5_lam(PP P, int pidx, int n, float dt, float& lr, float& li, float& fr, float& fi) {
    const float are = P->in[12][pidx * 64 + n], aim = P->in[13][pidx * 64 + n];
    const float mag = expf(are * dt); lr = mag * cosf(aim * dt); li = mag * sinf(aim * dt);
    const float den = are * are + aim * aim, nr = lr - 1.f;
    fr = (nr * are + li * aim) / den; fi = (li * are - nr * aim) / den;
}
__device__ __forceinline__ void s5_unit(PP P, LAS unsigned char* lds, int layer, int unit) {
    const int tid = otid(), wid = tid >> 6, lane = tid & 63, c = lane & 15, g = lane >> 4;
    const int b = unit >> 6, grp = (unit >> 1) & 31, dir = unit & 1;
    const int pidx = (layer * 2 + dir) * 32 + grp;
    const bf16_t* Ug = (const bf16_t*)(lws(P->ws) + OFF_U) + (size_t)(b * 32 + grp) * NKEY * 16;
    float* YD = (float*)(lws(P->ws) + OFF_YDIR) + (size_t)dir * MT * 512;
    LAS float* ends = (LAS float*)lds;
    const float dt = expf(P->in[14][pidx]);
    LAS float* lamt = (LAS float*)(lds + 65536);
    if (tid < 64) { float a0, a1, a2, a3; s5_lam(P, pidx, tid, dt, a0, a1, a2, a3); *(LAS f32x4*)(lamt + 4 * tid) = (f32x4){a0, a1, a2, a3}; }
    __syncthreads();
    f32x4 lr[4], li[4];
#pragma unroll
    for (int t4 = 0; t4 < 4; ++t4)
#pragma unroll
        for (int r = 0; r < 4; ++r) { const f32x4 q = *(const LAS f32x4*)(lamt + 4 * (16 * t4 + 4 * g + r)); lr[t4][r] = q.x; li[t4][r] = q.y; }
    bf16x8 bfr[8];
#pragma unroll
    for (int t4 = 0; t4 < 4; ++t4) {
        const int n = 16 * t4 + c; const f32x4 q = *(const LAS f32x4*)(lamt + 4 * n); const float fr = q.z, fi = q.w;
        u32x4 wr = (u32x4){0u, 0u, 0u, 0u}, wi = (u32x4){0u, 0u, 0u, 0u};
        if (g < 2) {
            const float* bre = P->in[15] + ((size_t)pidx * 64 + n) * 16 + 8 * g; const float* bim = P->in[16] + ((size_t)pidx * 64 + n) * 16 + 8 * g;
            const f32x4 r0 = *(const f32x4*)bre, r1 = *(const f32x4*)(bre + 4), i0 = *(const f32x4*)bim, i1 = *(const f32x4*)(bim + 4);
            const f32x4 ar0 = r0 * fr - i0 * fi, ar1 = r1 * fr - i1 * fi, ai0 = i0 * fr + r0 * fi, ai1 = i1 * fr + r1 * fi;
            wr = pack8(ar0, ar1); wi = pack8(ai0, ai1);
        }
        bfr[t4] = __builtin_bit_cast(bf16x8, wr); bfr[4 + t4] = __builtin_bit_cast(bf16x8, wi);
    }
    bf16x8 cfr[4];
#pragma unroll
    for (int f = 0; f < 4; ++f) {
        const float* cp = (f < 2 ? P->in[17] : P->in[18]) + ((size_t)pidx * 16 + c) * 64 + 32 * (f & 1) + 4 * g;
        f32x4 a = *(const f32x4*)cp, bq = *(const f32x4*)(cp + 16);
        if (f >= 2) { a = -a; bq = -bq; }
        cfr[f] = __builtin_bit_cast(bf16x8, pack8(a, bq));
    }
    const int seg = wid * 16 + c, s0 = 18 * seg;
    f32x4 hr[4], hi[4];
#pragma unroll
    for (int t4 = 0; t4 < 4; ++t4)
#pragma unroll
        for (int r = 0; r < 4; ++r) { hr[t4][r] = 0.f; hi[t4][r] = 0.f; }
    const f32x4 zero4 = (f32x4){0.f, 0.f, 0.f, 0.f};
#pragma unroll 3
    for (int t = 0; t < 18; ++t) {
        u32x4 uw = (u32x4){0u, 0u, 0u, 0u};
        if (g < 2) uw = *(const u32x4*)(Ug + (size_t)s5_key(dir, s0 + t) * 16 + 8 * g);
        const bf16x8 uf = __builtin_bit_cast(bf16x8, uw);
        f32x4 acc[8];
#pragma unroll
        for (int q = 0; q < 8; ++q) acc[q] = __builtin_amdgcn_mfma_f32_16x16x32_bf16(bfr[q], uf, zero4, 0, 0, 0);
#pragma unroll
        for (int t4 = 0; t4 < 4; ++t4)
            { const f32x4 a = lr[t4] * hr[t4] - li[t4] * hi[t4] + acc[t4], d = lr[t4] * hi[t4] + li[t4] * hr[t4] + acc[4 + t4]; hr[t4] = a; hi[t4] = d; }
    }
#pragma unroll
    for (int t4 = 0; t4 < 4; ++t4) {
        *(LAS f32x4*)(ends + seg * 128 + 16 * t4 + 4 * g) = hr[t4];
        *(LAS f32x4*)(ends + seg * 128 + 64 + 16 * t4 + 4 * g) = hi[t4];
    }
    __syncthreads();
    if (wid == 0) {
        const f32x4 q = *(const LAS f32x4*)(lamt + 4 * lane); const float l0 = q.x, l1 = q.y;
        float p2r = l0 * l0 - l1 * l1, p2i = 2.f * l0 * l1, qr = p2r, qi = p2i;
#pragma unroll
        for (int i = 0; i < 3; ++i) { const float a = qr * qr - qi * qi, d = 2.f * qr * qi; qr = a; qi = d; }
        const float Lr = qr * p2r - qi * p2i, Li = qr * p2i + qi * p2r;
        float ir = 0.f, ii = 0.f;
#pragma unroll 4
        for (int j = 0; j < 128; ++j) { const float er = ends[j * 128 + lane], ei = ends[j * 128 + 64 + lane];
            ends[j * 128 + lane] = ir; ends[j * 128 + 64 + lane] = ii;
            const float a = Lr * ir - Li * ii + er, d = Lr * ii + Li * ir + ei; ir = a; ii = d; }
    }
    __syncthreads();
#pragma unroll
    for (int t4 = 0; t4 < 4; ++t4) {
        const f32x4 a = *(const LAS f32x4*)(ends + seg * 128 + 16 * t4 + 4 * g), d = *(const LAS f32x4*)(ends + seg * 128 + 64 + 16 * t4 + 4 * g);
#pragma unroll
        for (int r = 0; r < 4; ++r) { hr[t4][r] = a[r]; hi[t4][r] = d[r]; }
    }
#pragma unroll 3
    for (int t = 0; t < 18; ++t) {
        const int row = s5_row(b, dir, s0 + t);
        u32x4 uw = (u32x4){0u, 0u, 0u, 0u};
        if (g < 2) uw = *(const u32x4*)(Ug + (size_t)s5_key(dir, s0 + t) * 16 + 8 * g);
        const bf16x8 uf = __builtin_bit_cast(bf16x8, uw);
        f32x4 acc[8];
#pragma unroll
        for (int q = 0; q < 8; ++q) acc[q] = __builtin_amdgcn_mfma_f32_16x16x32_bf16(bfr[q], uf, zero4, 0, 0, 0);
#pragma unroll
        for (int t4 = 0; t4 < 4; ++t4)
            { const f32x4 a = lr[t4] * hr[t4] - li[t4] * hi[t4] + acc[t4], d = lr[t4] * hi[t4] + li[t4] * hr[t4] + acc[4 + t4]; hr[t4] = a; hi[t4] = d; }
        f32x4 y = zero4;
#pragma unroll
        for (int f = 0; f < 4; ++f) {
            const int ta = 2 * (f & 1), tb = ta + 1;
            u32x4 w;
            if (f < 2) { w.x = cvt_pk_bf16(hr[ta][0], hr[ta][1]); w.y = cvt_pk_bf16(hr[ta][2], hr[ta][3]); w.z = cvt_pk_bf16(hr[tb][0], hr[tb][1]); w.w = cvt_pk_bf16(hr[tb][2], hr[tb][3]); }
            else       { w.x = cvt_pk_bf16(hi[ta][0], hi[ta][1]); w.y = cvt_pk_bf16(hi[ta][2], hi[ta][3]); w.z = cvt_pk_bf16(hi[tb][0], hi[tb][1]); w.w = cvt_pk_bf16(hi[tb][2], hi[tb][3]); }
            y = __builtin_amdgcn_mfma_f32_16x16x32_bf16(cfr[f], __builtin_bit_cast(bf16x8, w), y, 0, 0, 0);
        }
        *(f32x4*)(YD + (size_t)row * 512 + grp * 16 + 4 * g) = y;
    }
    __syncthreads();
}
__device__ __forceinline__ void phase_s5(PP P, LAS unsigned char* lds, int layer, int G) {
    for (int u = obid(); u < 256; u += G) s5_unit(P, lds, layer, u);
    const int tid = otid(), wid = tid >> 6, lane = tid & 63;
    const bf16_t* CQ = (const bf16_t*)(lws(P->ws) + OFF_CQ); const bf16_t* CKV = (const bf16_t*)(lws(P->ws) + OFF_CKV);
    float* RSQ = (float*)(lws(P->ws) + OFF_RSQ); float* RSKV = (float*)(lws(P->ws) + OFF_RSKV);
    for (int row = obid() * NWAVES + wid; row < MT; row += G * NWAVES) {
        float s = 0.f;
#pragma unroll
        for (int j = 0; j < 3; ++j) { const u32x2 w = *(const u32x2*)(CQ + (size_t)row * 768 + 4 * (lane + 64 * j)); const float a = bf_lo(w.x), b = bf_hi(w.x), c = bf_lo(w.y), d = bf_hi(w.y); s += a * a + b * b + c * c + d * d; }
        s = wave_sum(s);
        float s2 = 0.f;
        { const u32x4 w = *(const u32x4*)(CKV + (size_t)row * 512 + 8 * lane);
          float a;
          a = bf_lo(w.x); s2 += a * a; a = bf_hi(w.x); s2 += a * a; a = bf_lo(w.y); s2 += a * a; a = bf_hi(w.y); s2 += a * a;
          a = bf_lo(w.z); s2 += a * a; a = bf_hi(w.z); s2 += a * a; a = bf_lo(w.w); s2 += a * a; a = bf_hi(w.w); s2 += a * a; }
        s2 = wave_sum(s2);
        if (lane == 0) { RSQ[row] = rsqrtf(s * (1.f / 768.f) + EPSN); RSKV[row] = rsqrtf(s2 * (1.f / 512.f) + EPSN); }
    }
}
__device__ __forceinline__ void phase_ycombine(PP P, int layer, int G) {
    const bf16_t* U = (const bf16_t*)(lws(P->ws) + OFF_U); const float* YD = (const float*)(lws(P->ws) + OFF_YDIR); bf16_t* Gb = (bf16_t*)(lws(P->ws) + OFF_G);
    const float* dsk = P->in[19] + layer * 512;
    for (int i = obid() * 512 + otid(); i < MT * 128; i += G * 512) {
        const int row = i >> 7, c = (i & 127) * 4;
        bool lat; int bb, tt, kidx; row_decode(row, lat, bb, tt, kidx);
        const u32x2 w = *(const u32x2*)(U + (((size_t)(bb * 32 + (c >> 4)) * NKEY + kidx) << 4) + (c & 15));
        const f32x4 yf = *(const f32x4*)(YD + (size_t)row * 512 + c), yb = *(const f32x4*)(YD + (size_t)(MT + row) * 512 + c), d = *(const f32x4*)(dsk + c);
        f32x4 y = (f32x4){bf_lo(w.x), bf_hi(w.x), bf_lo(w.y), bf_hi(w.y)} * d + yf + yb;
#pragma unroll
        for (int e = 0; e < 4; ++e) { const float x = y[e], z = 0.7978845608028654f * (x + 0.044715f * x * x * x); const float th = 1.f - 2.f / (1.f + __expf(2.f * z)); y[e] = 0.5f * x * (1.f + th); }
        u32x2 o; o.x = cvt_pk_bf16(y.x, y.y); o.y = cvt_pk_bf16(y.z, y.w); *(u32x2*)(Gb + (size_t)row * 512 + c) = o;
    }
}

template <int NKR>
__device__ __forceinline__ void attn_block(LAS unsigned char* lds,
                                           const bf16_t* qa, int qa_stride, const bf16_t* qb, int qb_stride,
                                           const bf16_t* ka, const bf16_t* kb, const bf16_t* vt,
                                           int n0, int k1_beg, int n1, int qpos0,
                                           float cscale, float m_init, float l_init, bf16_t* out, int out_stride) {
    constexpr int KROWB = (128 + 32 * NKR) * 2 + 32, VROWB = 160,   VOFF = 64 * KROWB, BUFB = VOFF + 128 * VROWB;
    const int tid = otid(), wid = __builtin_amdgcn_readfirstlane(tid >> 6), lane = tid & 63, fr = lane & 15, g = lane >> 4;
    const int nt = n0 + n1;
    bf16x8 qf[2][4 + NKR];
#pragma unroll
    for (int qt = 0; qt < 2; ++qt) {
#pragma unroll
        for (int ks = 0; ks < 4; ++ks) qf[qt][ks] = *(const bf16x8*)(qa + (size_t)(wid * 32 + qt * 16 + fr) * qa_stride + ks * 32 + 8 * g);
#pragma unroll
        for (int ks = 0; ks < NKR; ++ks) qf[qt][4 + ks] = *(const bf16x8*)(qb + (size_t)(wid * 32 + qt * 16 + fr) * qb_stride + ks * 32 + 8 * g);
    }
    f32x4 oacc[8][2];
#pragma unroll
    for (int dt = 0; dt < 8; ++dt) { oacc[dt][0] = (f32x4){0.f, 0.f, 0.f, 0.f}; oacc[dt][1] = (f32x4){0.f, 0.f, 0.f, 0.f}; }
    float mrun[2] = {m_init, m_init}, lrun[2] = {g == 0 ? l_init : 0.f, g == 0 ? l_init : 0.f};
    u32x4 sk[2], sr, sv[2];
    const int krow = tid >> 4, kcc = tid & 15, rrow = tid >> 3, rcc = tid & 7;
#define ATT_LOADK(kb0) do { \
        sk[0] = *(const u32x4*)(ka + (size_t)((kb0) + krow) * 128 + kcc * 8); sk[1] = *(const u32x4*)(ka + (size_t)((kb0) + 32 + krow) * 128 + kcc * 8); \
        if (NKR) sr = *(const u32x4*)(kb + (size_t)((kb0) + rrow) * 64 + rcc * 8); } while (0)
#define ATT_STOREK(buf) do { LAS unsigned char* _b = lds + (buf) * BUFB; \
        *(LAS u32x4*)(_b + krow * KROWB + kcc * 16) = sk[0]; *(LAS u32x4*)(_b + (32 + krow) * KROWB + kcc * 16) = sk[1]; \
        if (NKR) *(LAS u32x4*)(_b + rrow * KROWB + 256 + rcc * 16) = sr; } while (0)
#define ATT_LOADV(kb0) do { \
        sv[0] = *(const u32x4*)(vt + (size_t)rrow * NKEY + (kb0) + rcc * 8); sv[1] = *(const u32x4*)(vt + (size_t)(64 + rrow) * NKEY + (kb0) + rcc * 8); } while (0)
#define ATT_STOREV(buf) do { LAS unsigned char* _b = lds + (buf) * BUFB; \
        *(LAS u32x4*)(_b + VOFF + rrow * VROWB + rcc * 16) = sv[0]; *(LAS u32x4*)(_b + VOFF + (64 + rrow) * VROWB + rcc * 16) = sv[1]; } while (0)
    { const int k00 = n0 > 0 ? 0 : k1_beg; ATT_LOADK(k00); ATT_STOREK(0); ATT_LOADV(k00); ATT_STOREV(0); }
    __syncthreads();
#pragma unroll 1
    for (int i = 0; i < nt; ++i) {
        const int kbase = i < n0 ? 64 * i : k1_beg + 64 * (i - n0);
        const bool msk = i >= n0;
        const int kn = (i + 1) < n0 ? 64 * (i + 1) : k1_beg + 64 * (i + 1 - n0);
        bool active = true;
        if (msk) { const int kp = kbase - CTXL, qw = qpos0 + 32 * wid; active = (kp < qw + 160) && (kp + 64 > qw - 128); }
        const LAS unsigned char* kbuf = lds + (i & 1) * BUFB; const LAS unsigned char* vbuf = kbuf + VOFF;
        f32x4 st[4][2];
        if (active) {
#pragma unroll
            for (int kt = 0; kt < 4; ++kt) { st[kt][0] = (f32x4){0.f, 0.f, 0.f, 0.f}; st[kt][1] = (f32x4){0.f, 0.f, 0.f, 0.f}; }
            bf16x8 kf[2][4];
#pragma unroll
            for (int kt = 0; kt < 4; ++kt) kf[0][kt] = *(const LAS bf16x8*)(kbuf + (kt * 16 + fr) * KROWB + g * 16);
#pragma unroll
            for (int ks = 0; ks < 4 + NKR; ++ks) {
                if (ks + 1 < 4 + NKR) {
#pragma unroll
                    for (int kt = 0; kt < 4; ++kt) kf[(ks + 1) & 1][kt] = *(const LAS bf16x8*)(kbuf + (kt * 16 + fr) * KROWB + (ks + 1) * 64 + g * 16);
                }
#pragma unroll
                for (int kt = 0; kt < 4; ++kt) {
                    st[kt][0] = __builtin_amdgcn_mfma_f32_16x16x32_bf16(kf[ks & 1][kt], qf[0][ks], st[kt][0], 0, 0, 0);
                    st[kt][1] = __builtin_amdgcn_mfma_f32_16x16x32_bf16(kf[ks & 1][kt], qf[1][ks], st[kt][1], 0, 0, 0); }
                __builtin_amdgcn_sched_barrier(0);
            }
        }
        if (i + 1 < nt) { ATT_LOADK(kn); ATT_LOADV(kn); }
        if (active) {
            bf16x8 pb[2][2];
#pragma unroll
            for (int qt = 0; qt < 2; ++qt) {
                f32x4 tv[4]; float mxr = -3.0e38f;
#pragma unroll
                for (int kt = 0; kt < 4; ++kt) { tv[kt] = st[kt][qt];
                    if (msk) {
#pragma unroll
                        for (int r = 0; r < 4; ++r) { const int kpos = kbase + kt * 16 + 4 * g + r - CTXL, qpos = qpos0 + wid * 32 + qt * 16 + fr; const int dlt = qpos - kpos; if (dlt > 128 || dlt < -128) tv[kt][r] = -1e30f; } }
                    mxr = fmaxf(mxr, fmaxf(fmaxf(tv[kt].x, tv[kt].y), fmaxf(tv[kt].z, tv[kt].w))); }
                mxr = fmaxf(mxr, __shfl_xor(mxr, 16)); mxr = fmaxf(mxr, __shfl_xor(mxr, 32));
                const float mxs = mxr * cscale;
                float mx = mrun[qt], alpha = 1.f;
                if (__any(mxs > mrun[qt] + 8.f)) {
                    mx = fmaxf(mrun[qt], mxs); alpha = __builtin_amdgcn_exp2f(mrun[qt] - mx); mrun[qt] = mx;
#pragma unroll
                    for (int dt = 0; dt < 8; ++dt) oacc[dt][qt] *= alpha;
                }
#pragma unroll
                for (int kt = 0; kt < 4; ++kt) { const f32x4 e = tv[kt] * cscale - mx;
                    tv[kt] = (f32x4){__builtin_amdgcn_exp2f(e.x), __builtin_amdgcn_exp2f(e.y), __builtin_amdgcn_exp2f(e.z), __builtin_amdgcn_exp2f(e.w)}; }
                const f32x4 ps4 = (tv[0] + tv[1]) + (tv[2] + tv[3]);
                const float ps = (ps4.x + ps4.y) + (ps4.z + ps4.w);
                lrun[qt] = lrun[qt] * alpha + ps;
#pragma unroll
                for (int G2 = 0; G2 < 2; ++G2) { u32x4 w; w.x = cvt_pk_bf16(tv[2 * G2][0], tv[2 * G2][1]); w.y = cvt_pk_bf16(tv[2 * G2][2], tv[2 * G2][3]);
                    w.z = cvt_pk_bf16(tv[2 * G2 + 1][0], tv[2 * G2 + 1][1]); w.w = cvt_pk_bf16(tv[2 * G2 + 1][2], tv[2 * G2 + 1][3]); pb[qt][G2] = __builtin_bit_cast(bf16x8, w); }
            }
            __builtin_amdgcn_sched_barrier(0);
            bf16x8 vf[2][2];
#pragma unroll
            for (int q = 0; q < 2; ++q) vf[0][q] = *(const LAS bf16x8*)(vbuf + fr * VROWB + q * 64 + g * 16);
#pragma unroll
            for (int dt = 0; dt < 8; ++dt) {
                if (dt + 1 < 8) {
#pragma unroll
                    for (int q = 0; q < 2; ++q) vf[(dt + 1) & 1][q] = *(const LAS bf16x8*)(vbuf + ((dt + 1) * 16 + fr) * VROWB + q * 64 + g * 16);
                }
#pragma unroll
                for (int q = 0; q < 2; ++q) {
                    oacc[dt][0] = __builtin_amdgcn_mfma_f32_16x16x32_bf16(vf[dt & 1][q], pb[0][q], oacc[dt][0], 0, 0, 0);
                    oacc[dt][1] = __builtin_amdgcn_mfma_f32_16x16x32_bf16(vf[dt & 1][q], pb[1][q], oacc[dt][1], 0, 0, 0); }
                __builtin_amdgcn_sched_barrier(0);
            }
        }
        if (i + 1 < nt) { ATT_STOREK((i + 1) & 1); ATT_STOREV((i + 1) & 1); }
        __syncthreads();
    }
#undef ATT_LOADK
#undef ATT_STOREK
#undef ATT_LOADV
#undef ATT_STOREV
#pragma unroll
    for (int qt = 0; qt < 2; ++qt) {
        float l = lrun[qt]; l += __shfl_xor(l, 16); l += __shfl_xor(l, 32);
        const float inv = 1.f / l;
#pragma unroll
        for (int dt = 0; dt < 8; ++dt) { const f32x4 o = oacc[dt][qt] * inv; u32x2 w; w.x = cvt_pk_bf16(o.x, o.y); w.y = cvt_pk_bf16(o.z, o.w);
            *(u32x2*)(out + (size_t)(wid * 32 + qt * 16 + fr) * out_stride + dt * 16 + 4 * g) = w; }
    }
}
constexpr float LOG2E = 1.4426950408889634f;
__device__ __forceinline__ void mla_unit(PP P, LAS unsigned char* lds, bool ctxq, int b, int h, int qb) {
    const bf16_t* QM = (const bf16_t*)(lws(P->ws) + OFF_QM); const bf16_t* KN = (const bf16_t*)(lws(P->ws) + OFF_KN); const bf16_t* KR = (const bf16_t*)(lws(P->ws) + OFF_KR);
    const bf16_t* VTM = (const bf16_t*)(lws(P->ws) + OFF_VTM); bf16_t* MIX = (bf16_t*)(lws(P->ws) + OFF_MIX);
    const int row0 = ctxq ? ML + b * CTXL : b * SEQ + 256 * qb;
    attn_block<2>(lds, QM + (size_t)row0 * UQW + h * 128, UQW, QM + (size_t)row0 * UQW + 768 + h * 64, UQW,
                  KN + (size_t)(b * 6 + h) * NKEY * 128, KR + (size_t)b * NKEY * 64, VTM + (size_t)(b * 6 + h) * 128 * NKEY,
                  ctxq ? 4 : 36, 0, 0, 0, 0.07216878364870322f * LOG2E, -1e30f, 0.f, MIX + (size_t)row0 * DM + 1280 + h * 128, DM);
}
__device__ __forceinline__ void swa_unit(PP P, LAS unsigned char* lds, int layer, bool ctxq, int b, int h, int qb) {
    const bf16_t* QS = (const bf16_t*)(lws(P->ws) + OFF_QS); const bf16_t* KS = (const bf16_t*)(lws(P->ws) + OFF_KS); const bf16_t* VTS = (const bf16_t*)(lws(P->ws) + OFF_VTS);
    bf16_t* MIX = (bf16_t*)(lws(P->ws) + OFF_MIX);
    const int q0 = 256 * qb, row0 = ctxq ? ML + b * CTXL : b * SEQ + q0;
    int k1 = 0, n1 = 0;
    if (!ctxq) { const int lo = q0 - 128 < 0 ? 0 : q0 - 128, hi = q0 + 384 > SEQ ? SEQ : q0 + 384; k1 = CTXL + lo; n1 = (hi - lo) >> 6; }
    const int kvh = h / 3;
    const float sink = P->in[22][layer * 6 + h] * LOG2E;
    attn_block<0>(lds, QS + (size_t)row0 * 768 + h * 128, 768, nullptr, 0,
                  KS + (size_t)(b * 2 + kvh) * NKEY * 128, nullptr, VTS + (size_t)(b * 2 + kvh) * 128 * NKEY,
                  4, k1, n1, q0, 0.08838834764831845f * LOG2E, sink, 1.f, MIX + (size_t)row0 * DM + 512 + h * 128, DM);
}
__device__ __forceinline__ void phase_att(PP P, LAS unsigned char* lds, int layer, bool need_ctx, int bid) {
    const int x = bid & 7;
    if (bid < 192) { const int j = bid >> 3, bh = x * 3 + (j >> 3); mla_unit(P, lds, false, bh / 6, bh % 6, j & 7); }
    else {
        const int y = (bid - 192) >> 3;
#pragma unroll 1
        for (int r = 0; r < 3; ++r) { const int bh = r * 8 + x; swa_unit(P, lds, layer, false, bh / 6, bh % 6, y); }
        const int j = bid - 192;
        if (need_ctx) { if (j < 24) mla_unit(P, lds, true, j / 6, j % 6, 0); else if (j < 48) swa_unit(P, lds, layer, true, (j - 24) / 6, (j - 24) % 6, 0); }
    }
}

__global__ void __launch_bounds__(512, 2) mega_fwd(Params Pval) {
#define P (kparams())
    extern __shared__ __attribute__((aligned(16))) unsigned char lds_raw[];
    LAS unsigned char* lds = (LAS unsigned char*)lds_raw;
    cg::grid_group grid = cg::this_grid();
    const int G = gridDim.x;
#define bid (obid())
    volatile LAS unsigned* xst = (volatile LAS unsigned*)(lds + 131072);
    if (threadIdx.x == 0) { xst[0] = 0u; xst[1] = 0u; }
    __syncthreads();
    (void)xcd_barrier_post((unsigned*)(lws(P->ws) + OFF_BAR), xst);
#define GRID_BARRIER() do { XcdBarrier xb_; xb_.bar = (unsigned*)(lws(P->ws) + OFF_BAR); xb_.x = xb_xcc_id(); xb_.st = (volatile LAS unsigned*)(lds + 131072); xcd_barrier(xb_); } while (0)

#ifndef SKIP_PREP
    phase_prep(P, lds, G);
#ifdef DUP_PREP
    __syncthreads();
    phase_prep(P, lds, G);
#endif
#endif
    if (P->ws == nullptr) grid.sync();
    GRID_BARRIER();
#ifndef SKIP_ROWS
    phase_rows(P, 0, 0, G);
#endif
    GRID_BARRIER();
#pragma unroll 1
    for (int layer = 0; layer < 2; ++layer) {
        const bool need_ctx = layer == 0;
        const int Mo = need_ctx ? MT : ML;
        { Gemm g{(const bf16_t*)(lws(P->ws) + OFF_H), (const bf16_t*)(lws(P->ws) + (size_t)layer * WL_STRIDE + OFF_WIN), MT, INWP, DM, DM, DM}; StaticOrder S; S.init(MT, INWP, G, bid);
          EpiInProj E{lws(P->ws)};
#ifndef SKIP_G1

#ifdef DUP_G1
_Pragma("unroll 1")
          for (int rep = 0; rep < 2; ++rep)
#endif
          pg8::gemm_phase(lds, g, S, E);

#endif
        }
        GRID_BARRIER();
#ifndef SKIP_S5
        phase_s5(P, lds, layer, G);
#ifdef DUP_S5
        phase_s5(P, lds, layer, G);
#endif
#endif
        GRID_BARRIER();
#ifndef SKIP_YC
        phase_ycombine(P, layer, G);
#endif
        { Gemm g{(const bf16_t*)(lws(P->ws) + OFF_CQ), (const bf16_t*)(lws(P->ws) + (size_t)layer * WL_STRIDE + OFF_WUQ), Mo, UQWP, 768, 768, 768}; StaticOrder S; S.init(Mo, UQWP, G, bid);
          EpiUQ E{(bf16_t*)(lws(P->ws) + OFF_QM), (const float*)(lws(P->ws) + OFF_RSQ), (const float*)(lws(P->ws) + OFF_TMLA)};

#ifdef DUP_G2
_Pragma("unroll 1")
          for (int rep = 0; rep < 2; ++rep)
#endif
          pg8::gemm_phase(lds, g, S, E);
 }
        { Gemm g{(const bf16_t*)(lws(P->ws) + OFF_CKV), (const bf16_t*)(lws(P->ws) + (size_t)layer * WL_STRIDE + OFF_WUKV), MT, UKVW, 512, 512, 512}; StaticOrder S; S.init(MT, UKVW, G, (bid + 76) % G);
          EpiUKV E{(bf16_t*)(lws(P->ws) + OFF_KN), (bf16_t*)(lws(P->ws) + OFF_VTM), (const float*)(lws(P->ws) + OFF_RSKV)};

#ifdef DUP_G2
_Pragma("unroll 1")
          for (int rep = 0; rep < 2; ++rep)
#endif
          pg8::gemm_phase(lds, g, S, E);
 }
        GRID_BARRIER();
        {
#ifndef SKIP_ATT
            phase_att(P, lds, layer, need_ctx, bid);
#ifdef DUP_ATT
            phase_att(P, lds, layer, need_ctx, bid);
#endif
#endif
            __syncthreads();
            Gemm g{(const bf16_t*)(lws(P->ws) + OFF_G), (const bf16_t*)(lws(P->ws) + (size_t)layer * WL_STRIDE + OFF_WGLU), Mo, 512, 512, 512, 512}; StaticOrder S; S.init(Mo, 512, 64, bid >= 192 ? ((bid - 192 + 16) & 63) : -1);
            EpiGLU E{(const bf16_t*)(lws(P->ws) + OFF_G), P->in[21] + layer * 512, (bf16_t*)(lws(P->ws) + OFF_MIX)};

#ifdef DUP_GLU
_Pragma("unroll 1")
          for (int rep = 0; rep < 2; ++rep)
#endif
          pg8::gemm_phase(lds, g, S, E);

        }
        GRID_BARRIER();
        { Gemm g{(const bf16_t*)(lws(P->ws) + OFF_MIX), (const bf16_t*)(lws(P->ws) + (size_t)layer * WL_STRIDE + OFF_WOUT), ML, DM, DM, DM, DM}; StaticOrder S; S.init(ML, DM, G, bid);
          EpiBf16Out E{(bf16_t*)(lws(P->ws) + OFF_O), DM, 0};
#ifdef DUP_G3
_Pragma("unroll 1")
          for (int rep = 0; rep < 2; ++rep)
#endif
          pg8::gemm_phase(lds, g, S, E);
        }
        if (need_ctx) { Gemm g{(const bf16_t*)(lws(P->ws) + OFF_MIX) + (size_t)ML * DM, (const bf16_t*)(lws(P->ws) + (size_t)layer * WL_STRIDE + OFF_WOUT), MC, DM, 256, DM, DM}; StaticOrder S; S.init(MC, DM, G, bid, 8);
          EpiBf16Out E{(bf16_t*)(lws(P->ws) + OFF_OPART), DM, (size_t)MC * DM};
#ifdef DUP_G3
_Pragma("unroll 1")
          for (int rep = 0; rep < 2; ++rep)
#endif
          pg8::gemm_phase(lds, g, S, E);
        }
        GRID_BARRIER();
#ifndef SKIP_ROWS
        phase_rows(P, 1, layer, G);
#ifdef DUP_ROWS1
        if (layer == 0) phase_rows(P, 1, layer, G);
#endif
#endif
        GRID_BARRIER();
        { Gemm g{(const bf16_t*)(lws(P->ws) + OFF_H), (const bf16_t*)(lws(P->ws) + (size_t)layer * WL_STRIDE + OFF_W1), Mo, DFF, DM, DM, DM}; StaticOrder S; S.init(Mo, DFF, G, bid);
          EpiSqRelu E{(bf16_t*)(lws(P->ws) + OFF_A1), DFF};

#ifdef DUP_FFN1
_Pragma("unroll 1")
          for (int rep = 0; rep < 2; ++rep)
#endif
          pg8::gemm_phase(lds, g, S, E);
 }
        GRID_BARRIER();
        { Gemm g{(const bf16_t*)(lws(P->ws) + OFF_A1), (const bf16_t*)(lws(P->ws) + (size_t)layer * WL_STRIDE + OFF_W2), ML, DM, DFF, DFF, DFF}; StaticOrder S; S.init(ML, DM, G, bid);
          EpiBf16Out E{(bf16_t*)(lws(P->ws) + OFF_O), DM, 0};
#ifndef SKIP_GEMM6
          pg8::gemm_phase(lds, g, S, E);
#ifdef DUP_FFN2
          pg8::gemm_phase(lds, g, S, E);
#endif
#endif
        }
        if (need_ctx) { Gemm g{(const bf16_t*)(lws(P->ws) + OFF_A1) + (size_t)ML * DFF, (const bf16_t*)(lws(P->ws) + (size_t)layer * WL_STRIDE + OFF_W2), MC, DM, 1024, DFF, DFF}; StaticOrder S; S.init(MC, DM, G, bid, 8);
          EpiBf16Out E{(bf16_t*)(lws(P->ws) + OFF_OPART), DM, (size_t)MC * DM};
#ifndef SKIP_GEMM6
          pg8::gemm_phase(lds, g, S, E);
#ifdef DUP_FFN2
          pg8::gemm_phase(lds, g, S, E);
#endif
#endif
        }
        GRID_BARRIER();
#ifndef SKIP_ROWS
        phase_rows(P, 2, layer, G);
#endif
#ifdef DUP_SYNC
        for (int rep = 0; rep < 5; ++rep) GRID_BARRIER();
#endif
        if (layer == 0) GRID_BARRIER();
    }
#undef P
#undef bid
}

extern "C" void kernel_launch(void* const* d_in, const int* in_sizes, int n_in, void* d_out, int out_size, void* d_ws, size_t ws_size, hipStream_t stream) {
    static int grid = 0;
    if (grid == 0) {
        if (n_in != 29 || out_size != ML * DM || ws_size < WS_END) { fprintf(stderr, "kernel_launch: unexpected shapes (n_in %d out %d ws %zu need %zu)\n", n_in, out_size, ws_size, (size_t)WS_END); grid = -1; return; }
        int dev = 0, cus = 0, per_cu = 0;
        hipGetDevice(&dev);
        hipDeviceGetAttribute(&cus, hipDeviceAttributeMultiprocessorCount, dev);
        if (hipFuncSetAttribute((const void*)mega_fwd, hipFuncAttributeMaxDynamicSharedMemorySize, LDS_BYTES) != hipSuccess) { fprintf(stderr, "kernel_launch: hipFuncSetAttribute failed\n"); grid = -1; return; }
        hipOccupancyMaxActiveBlocksPerMultiprocessor(&per_cu, (const void*)mega_fwd, 512, LDS_BYTES);
        if (per_cu < 1 || cus < 256) { fprintf(stderr, "kernel_launch: occupancy %d cus %d\n", per_cu, cus); grid = -1; return; }
        grid = 256;
    }
    if (grid < 0) return;
    if (hipMemsetAsync((char*)d_ws + OFF_BAR, 0, 16384, stream) != hipSuccess) { fprintf(stderr, "kernel_launch: memset failed\n"); return; }
    Params p{};
    for (int i = 0; i < 29; ++i) p.in[i] = (const float*)d_in[i];
    p.out = (float*)d_out; p.ws = (unsigned char*)d_ws;
    void* args[] = {&p};
    hipError_t e = hipLaunchCooperativeKernel((const void*)mega_fwd, dim3(grid), dim3(512), args, LDS_BYTES, stream);
    if (e != hipSuccess) fprintf(stderr, "cooperative launch failed: %s\n", hipGetErrorString(e));
}
```

```cpp
#include <hip/hip_runtime.h>
#include <hip/hip_cooperative_groups.h>
#include <cstdio>
#include <cstdint>
namespace cg = cooperative_groups;

#define LAS __attribute__((address_space(3)))
typedef unsigned short bf16_t;
typedef short bf16x8 __attribute__((ext_vector_type(8)));
typedef float f32x4 __attribute__((ext_vector_type(4)));
typedef float f32x2 __attribute__((ext_vector_type(2)));
typedef unsigned u32x4 __attribute__((ext_vector_type(4)));
typedef unsigned u32x2 __attribute__((ext_vector_type(2)));

constexpr int DM = 2048, NBATCH = 4, SEQ = 2048, CTXL = 256, NKEY = SEQ + CTXL;
constexpr int ML = NBATCH * SEQ, MC = NBATCH * CTXL, MT = ML + MC;
constexpr int INW = 3136, INWP = 3328, DFF = 8192, UQW = 1152, UQWP = 1280, UKVW = 1536;
constexpr float EPSN = 1e-6f;
constexpr int LDS_BYTES = 131072 + 16;
constexpr int NWAVES = 8;

constexpr size_t SZ_WIN = (size_t)INWP * DM * 2, SZ_WOUT = (size_t)DM * DM * 2, SZ_WUQ = (size_t)UQWP * 768 * 2, SZ_WUKV = (size_t)UKVW * 512 * 2,
                 SZ_WGLU = (size_t)512 * 512 * 2, SZ_W1 = (size_t)DFF * DM * 2, SZ_W2 = (size_t)DM * DFF * 2;
constexpr size_t OFF_WIN = 0, OFF_WOUT = OFF_WIN + SZ_WIN, OFF_WUQ = OFF_WOUT + SZ_WOUT, OFF_WUKV = OFF_WUQ + SZ_WUQ, OFF_WGLU = OFF_WUKV + SZ_WUKV,
                 OFF_W1 = OFF_WGLU + SZ_WGLU, OFF_W2 = OFF_W1 + SZ_W1, WL_STRIDE = OFF_W2 + SZ_W2;
constexpr size_t OFF_MODS = 2 * WL_STRIDE;
constexpr size_t OFF_TSWA = OFF_MODS + (size_t)2 * 5 * 12288 * 4;
constexpr size_t OFF_TMLA = OFF_TSWA + (size_t)2048 * 64 * 8;
constexpr size_t OFF_XS = OFF_TMLA + (size_t)2048 * 32 * 8;
constexpr size_t OFF_H = OFF_XS + (size_t)MT * DM * 4;
constexpr size_t OFF_O = OFF_H + (size_t)MT * DM * 2;
constexpr size_t OFF_R = OFF_O + (size_t)MT * DM * 4;
constexpr size_t OFF_A1 = OFF_R;
constexpr size_t OFF_U = OFF_R;
constexpr size_t OFF_QS = OFF_U + (size_t)MT * 512 * 2;
constexpr size_t OFF_KS = OFF_QS + (size_t)MT * 768 * 2;
constexpr size_t OFF_VTS = OFF_KS + (size_t)NBATCH * 2 * NKEY * 128 * 2;
constexpr size_t OFF_CQ = OFF_VTS + (size_t)NBATCH * 2 * NKEY * 128 * 2;
constexpr size_t OFF_CKV = OFF_CQ + (size_t)MT * 768 * 2;
constexpr size_t OFF_KR = OFF_CKV + (size_t)MT * 512 * 2;
constexpr size_t OFF_RSQ = OFF_KR + (size_t)NBATCH * NKEY * 64 * 2;
constexpr size_t OFF_RSKV = OFF_RSQ + (size_t)MT * 4;
constexpr size_t OFF_YDIR = OFF_RSKV + (size_t)MT * 4;
constexpr size_t OFF_G = OFF_YDIR + (size_t)2 * MT * 512 * 4;
constexpr size_t OFF_QM = OFF_G + (size_t)MT * 512 * 2;
constexpr size_t OFF_KN = OFF_QM + (size_t)MT * UQW * 2;
constexpr size_t OFF_VTM = OFF_KN + (size_t)NBATCH * 6 * NKEY * 128 * 2;
constexpr size_t OFF_MIX = OFF_VTM + (size_t)NBATCH * 6 * NKEY * 128 * 2;
constexpr size_t END_MIXER = OFF_MIX + (size_t)MT * DM * 2;
constexpr size_t END_A1 = OFF_A1 + (size_t)MT * DFF * 2;
constexpr size_t OFF_BAR = ((END_MIXER > END_A1 ? END_MIXER : END_A1) + 255) & ~(size_t)255;
constexpr size_t OFF_OPART = OFF_BAR + 16384;
constexpr size_t WS_END = OFF_OPART + (size_t)8 * MC * DM * 4;

struct Params { const float* in[29]; float* out; unsigned char* ws; };
typedef const Params __attribute__((address_space(4)))* PP;
__device__ __forceinline__ PP kparams() { PP p = (PP)__builtin_amdgcn_kernarg_segment_ptr(); asm volatile("" : "+s"(p)); return p; }

__device__ __forceinline__ unsigned cvt_pk_bf16(float lo, float hi) { unsigned r; asm volatile("v_cvt_pk_bf16_f32 %0, %1, %2" : "=v"(r) : "v"(lo), "v"(hi)); return r; }
__device__ __forceinline__ float bf_lo(unsigned w) { return __uint_as_float(w << 16); }
__device__ __forceinline__ float bf_hi(unsigned w) { return __uint_as_float(w & 0xffff0000u); }
__device__ __forceinline__ float wave_sum(float v) {
#pragma unroll
    for (int o = 1; o < 64; o <<= 1) v += __shfl_xor(v, o);
    return v;
}
#define LDS_WAIT() asm volatile("s_waitcnt lgkmcnt(0)" ::: "memory")
__device__ __forceinline__ unsigned char* lws(unsigned char* p) { asm volatile("" : "+s"(p)); return p; }
__device__ __forceinline__ int obid() { int b = blockIdx.x; asm volatile("" : "+s"(b)); return b; }
__device__ __forceinline__ int otid() { int t = threadIdx.x; asm volatile("" : "+v"(t)); return t; }


#define XB_TMO      128
#define XB_XCNT(j)  (256  + 64 * (j))
#define XB_XSUB(j)  (1280 + 64 * (j))
#define XB_XGEN(j)  (2304 + 64 * (j))
#define XB_TOP      3328
#define XB_TOPGEN   3392
#define XCD_BAR_WORDS 3456
#define XB_SPIN_CAP (1u << 18)
__device__ __forceinline__ unsigned xb_ld(unsigned* p)              { return __hip_atomic_load(p, __ATOMIC_RELAXED, __HIP_MEMORY_SCOPE_AGENT); }
__device__ __forceinline__ unsigned xb_add(unsigned* p, unsigned v) { return __hip_atomic_fetch_add(p, v, __ATOMIC_RELAXED, __HIP_MEMORY_SCOPE_AGENT); }
__device__ __forceinline__ unsigned xb_xcc_id() { return (unsigned)__builtin_amdgcn_s_getreg((3 << 11) | 20) & 0xFu; }
#define XB_SPIN(cond, bar) do { unsigned _sp = 0; while (cond) { __builtin_amdgcn_s_sleep(1); \
    if ((++_sp & 255u) == 0u) { if (xb_ld(&(bar)[XB_TMO])) break; if (_sp > XB_SPIN_CAP) { atomicAdd(&(bar)[XB_TMO], 1u); break; } } } } while (0)
struct XcdBarrier { unsigned* bar; unsigned x; volatile LAS unsigned* st; };
__device__ __forceinline__ XcdBarrier xcd_barrier_post(unsigned* bar, volatile LAS unsigned* st) {
    XcdBarrier b; b.bar = bar; b.x = xb_xcc_id(); b.st = st;
    if (threadIdx.x == 0) (void)xb_add(&bar[XB_XCNT(b.x)], 1u);
    return b;
}
__device__ __forceinline__ void xcd_barrier_complete(unsigned* bar, unsigned x, unsigned& nloc, unsigned& nx) {
    const unsigned G = gridDim.x * gridDim.y * gridDim.z;
    unsigned sum, cnt, mine, sp = 0u;
    for (;;) {
        sum = 0u; cnt = 0u; mine = 0u;
#pragma unroll
        for (unsigned j = 0; j < 16; ++j) { const unsigned c = xb_ld(&bar[XB_XCNT(j)]); sum += c; cnt += (c > 0u) ? 1u : 0u; mine = (j == x) ? c : mine; }
        if (sum == G) break;
        __builtin_amdgcn_s_sleep(1);
        if ((++sp & 255u) == 0u) { if (xb_ld(&bar[XB_TMO])) break; if (sp > XB_SPIN_CAP) { atomicAdd(&bar[XB_TMO], 1u); break; } }
    }
    nloc = mine > 0u ? mine : 1u; nx = cnt > 0u ? cnt : 1u;
}
__device__ __forceinline__ void xcd_barrier(const XcdBarrier& b) {
    asm volatile("s_waitcnt vmcnt(0)" ::: "memory");
    __syncthreads();
    if (threadIdx.x == 0) {
        unsigned* bar = b.bar;
        __builtin_amdgcn_s_waitcnt(0);
        unsigned nloc = b.st[0], nx = b.st[1];
        if (nloc == 0u) { xcd_barrier_complete(bar, b.x, nloc, nx); b.st[0] = nloc; b.st[1] = nx; }
        const unsigned old = xb_add(&bar[XB_XSUB(b.x)], 1u);
        const unsigned gen = old / nloc;
        if (old + 1u == (gen + 1u) * nloc) {
            __builtin_amdgcn_fence(__ATOMIC_RELEASE, "agent");
            asm volatile("s_waitcnt vmcnt(0)" ::: "memory");
            const unsigned og = xb_add(&bar[XB_TOP], 1u);
            const unsigned tg = og / nx;
            if (og + 1u == (tg + 1u) * nx) xb_add(&bar[XB_TOPGEN], 1u);
            else XB_SPIN(xb_ld(&bar[XB_TOPGEN]) == tg, bar);
            __builtin_amdgcn_fence(__ATOMIC_ACQUIRE, "agent");
            xb_add(&bar[XB_XGEN(b.x)], 1u);
            asm volatile("s_waitcnt vmcnt(0)" ::: "memory");
        } else {
            XB_SPIN(xb_ld(&bar[XB_XGEN(b.x)]) == gen, bar);
            __builtin_amdgcn_fence(__ATOMIC_ACQUIRE, "agent");
            asm volatile("s_waitcnt vmcnt(0)" ::: "memory");
        }
    }
    __syncthreads();
}

namespace pg8 {
constexpr int BM = 256, BK = 64, HALF = 128, HTB = HALF * BK * 2, STAGE_BYTES = 8 * HTB, NXCD = 8, WGM = 8;
__host__ __device__ __forceinline__ int lds_byte(int r, int c) { const int st = (r >> 4) * 2 + (c >> 5), rr = r & 15, cc = c & 31, ob = rr * 64 + cc * 2; return st * 1024 + (ob ^ (((ob >> 9) & 1) << 5)); }
__host__ __device__ __forceinline__ void stage_rc(int b, int& R, int& C) { const int st = b / 1024, sb = b % 1024, swz = sb ^ (((sb >> 9) & 1) << 5); R = (st >> 1) * 16 + swz / 64; C = (st & 1) * 32 + (swz % 64) / 2; }
__host__ __device__ __forceinline__ int perm32(int rho) { const int n = rho >> 4, i = rho & 15; return 8 * (i >> 2) + 4 * n + (i & 3); }
struct Unit { int pm, pn, kc; };
struct Gemm { const bf16_t* A; const bf16_t* Bt; int M, N, K, lda, ldb; };
struct StaticOrder {
    int nM, nN, nwg, G, c, tiles;
    __host__ __device__ void init(int M, int N, int G_, int c_, int ksplit = 1) { nM = M / BM; nN = N / BM; tiles = nM * nN; nwg = tiles * ksplit; G = G_; c = c_; }
    __host__ __device__ bool next(int i, Unit& u) const {
        if (c < 0) return false;
        const long L = (long)i * G + c; if (L >= nwg) return false;
        u.kc = (int)L / tiles;
        int wgid = (int)L % tiles; { const int q = tiles / NXCD, r = tiles % NXCD, xcd = wgid % NXCD, off = wgid / NXCD; wgid = (xcd < r ? xcd * (q + 1) : r * (q + 1) + (xcd - r) * q) + off; }
        const int nig = WGM * nN, gid = wgid / nig, fm = gid * WGM, gsz = (nM - fm) < WGM ? (nM - fm) : WGM;
        u.pm = fm + ((wgid % nig) % gsz); u.pn = (wgid % nig) / gsz; return true;
    }
};
template <class Epi>
__device__ __forceinline__ void gemm_phase(LAS unsigned char* lds, const Gemm g, const StaticOrder& S, const Epi& E) {
    const int tid = otid(), wid = __builtin_amdgcn_readfirstlane(tid >> 6), lane = tid & 63, wr = wid >> 2, wc = wid & 3, fr = lane & 15, fq = lane >> 4;
    const int K = g.K, nt = K / BK;
    unsigned voffA, voffB;
    { int R, C; stage_rc(tid * 16, R, C); const int Rb = Epi::PERM ? ((R & ~31) + perm32(R & 31)) : R;
      voffA = (unsigned)(R * g.lda + C) * 2u; voffB = (unsigned)(Rb * g.ldb + C) * 2u; }
    const size_t r64voffA = (size_t)64 * g.lda * 2, r64voffB = (size_t)64 * g.ldb * 2;
    const size_t kstep = (size_t)(BK * 2);
    const size_t hstepA = (size_t)HALF * g.lda * 2, hstepB = (size_t)HALF * g.ldb * 2;
    const size_t tstepA = 2 * hstepA, tstepB = 2 * hstepB, cstep = (size_t)K * 2;
    const unsigned ldsw = (unsigned)wid * 1024u;
    const int aoff = lds_byte(wr * 64 + fr, fq * 8), boff = lds_byte(wc * 32 + fr, fq * 8);
#define PG8_SA(b, h) (((b) * 2 + (h)) * HTB)
#define PG8_SB(b, h) ((4 + (b) * 2 + (h)) * HTB)
#define PG8_STAGE(bufoff, gbase, voff) do { _Pragma("unroll") for (int _i = 0; _i < 2; ++_i) \
        __builtin_amdgcn_global_load_lds((const unsigned*)((const char*)(gbase) + _i * r64##voff + (voff)), (LAS unsigned*)(lds + (bufoff) + ldsw + _i * 8192), 16, 0, 0); } while (0)
#define PG8_LDA(dst, b, h) do { _Pragma("unroll") for (int m = 0; m < 4; ++m) _Pragma("unroll") for (int k = 0; k < 2; ++k) dst[m][k] = *(const LAS bf16x8*)(lds + PG8_SA(b, h) + aoff + m * 2048 + k * 1024); } while (0)
#define PG8_LDB(dst, b, h) do { _Pragma("unroll") for (int n = 0; n < 2; ++n) _Pragma("unroll") for (int k = 0; k < 2; ++k) dst[n][k] = *(const LAS bf16x8*)(lds + PG8_SB(b, h) + boff + n * 2048 + k * 1024); } while (0)
#define PG8_MMA(ai, bj, At, Bt) do { __builtin_amdgcn_s_setprio(1); _Pragma("unroll") for (int m = 0; m < 4; ++m) _Pragma("unroll") for (int n = 0; n < 2; ++n) _Pragma("unroll") for (int k = 0; k < 2; ++k) \
        acc[ai][bj][m][n] = __builtin_amdgcn_mfma_f32_16x16x32_bf16(Bt[n][k], At[m][k], acc[ai][bj][m][n], 0, 0, 0); __builtin_amdgcn_s_setprio(0); } while (0)
#define PG8_WAIT_V(n) asm volatile("s_waitcnt vmcnt(" #n ")" ::: "memory")
#define PG8_WAIT_L(n) asm volatile("s_waitcnt lgkmcnt(" #n ")" ::: "memory")
#define PG8_BAR __builtin_amdgcn_s_barrier()
#define PG8_SCHED __builtin_amdgcn_sched_barrier(0)
    Unit cur, nxt; int ui = 0;
    if (!S.next(0, cur)) return;
    f32x4 acc[2][2][4][2];
#pragma unroll
    for (int a = 0; a < 2; ++a)
#pragma unroll
        for (int b = 0; b < 2; ++b)
#pragma unroll
            for (int m = 0; m < 4; ++m)
#pragma unroll
                for (int n = 0; n < 2; ++n) acc[a][b][m][n] = (f32x4){0.f, 0.f, 0.f, 0.f};
    bf16x8 At[4][2], B0[2][2], B1[2][2];
    const char* cA = (const char*)g.A + (size_t)cur.pm * tstepA + (size_t)cur.kc * cstep; const char* cB = (const char*)g.Bt + (size_t)cur.pn * tstepB + (size_t)cur.kc * cstep;
    PG8_STAGE(PG8_SB(0, 0), cB, voffB); PG8_STAGE(PG8_SB(0, 1), cB + hstepB, voffB); PG8_STAGE(PG8_SA(0, 0), cA, voffA); PG8_STAGE(PG8_SA(0, 1), cA + hstepA, voffA);
    if (wr == 1) PG8_BAR;
    PG8_WAIT_V(2); PG8_BAR;
    PG8_STAGE(PG8_SB(1, 0), cB + kstep, voffB); PG8_STAGE(PG8_SA(1, 0), cA + kstep, voffA); PG8_STAGE(PG8_SB(1, 1), cB + hstepB + kstep, voffB);
    PG8_WAIT_V(6); PG8_BAR;
    for (;;) {
        const bool has_next = S.next(ui + 1, nxt);
        const char* nA = has_next ? (const char*)g.A + (size_t)nxt.pm * tstepA + (size_t)nxt.kc * cstep : cA; const char* nB = has_next ? (const char*)g.Bt + (size_t)nxt.pn * tstepB + (size_t)nxt.kc * cstep : cB;
        for (int t = 0; t < nt; t += 2) {
            const bool last = (t == nt - 2);
            const char* a1 = cA + (size_t)(t + 1) * kstep;
            const char* a2 = last ? nA : cA + (size_t)(t + 2) * kstep; const char* b2 = last ? nB : cB + (size_t)(t + 2) * kstep;
            const char* a3 = a2 + kstep; const char* b3 = b2 + kstep;
            PG8_LDB(B0, 0, 0); PG8_LDB(B1, 0, 1); PG8_SCHED; PG8_LDA(At, 0, 0); PG8_STAGE(PG8_SA(1, 1), a1 + hstepA, voffA);
            PG8_WAIT_V(8); PG8_WAIT_L(0); PG8_BAR; PG8_MMA(0, 0, At, B0); PG8_MMA(0, 1, At, B1); PG8_BAR; PG8_SCHED;
            PG8_LDA(At, 0, 1); PG8_STAGE(PG8_SB(0, 0), b2, voffB); PG8_STAGE(PG8_SB(0, 1), b2 + hstepB, voffB); PG8_STAGE(PG8_SA(0, 0), a2, voffA);
            PG8_WAIT_V(8); PG8_WAIT_L(0); PG8_BAR; PG8_MMA(1, 0, At, B0); PG8_MMA(1, 1, At, B1); PG8_BAR; PG8_SCHED;
            PG8_LDB(B0, 1, 0); PG8_LDB(B1, 1, 1); PG8_SCHED; PG8_LDA(At, 1, 0); PG8_STAGE(PG8_SA(0, 1), a2 + hstepA, voffA);
            PG8_WAIT_V(8); PG8_WAIT_L(0); PG8_BAR; PG8_MMA(0, 0, At, B0); PG8_MMA(0, 1, At, B1); PG8_BAR; PG8_SCHED;
            PG8_LDA(At, 1, 1); PG8_STAGE(PG8_SB(1, 0), b3, voffB); PG8_STAGE(PG8_SB(1, 1), b3 + hstepB, voffB); PG8_STAGE(PG8_SA(1, 0), a3, voffA);
            PG8_WAIT_V(8); PG8_WAIT_L(0); PG8_BAR; PG8_MMA(1, 0, At, B0); PG8_MMA(1, 1, At, B1); PG8_BAR; PG8_SCHED;
        }
        if (wr == 0) PG8_BAR;
        E(acc, cur, wr, wc, fr, fq);
        if (!has_next) break;
#pragma unroll
        for (int a = 0; a < 2; ++a)
#pragma unroll
            for (int b = 0; b < 2; ++b)
#pragma unroll
                for (int m = 0; m < 4; ++m)
#pragma unroll
                    for (int n = 0; n < 2; ++n) acc[a][b][m][n] = (f32x4){0.f, 0.f, 0.f, 0.f};
        cur = nxt; cA = nA; cB = nB; ++ui;
        if (wr == 1) PG8_BAR;
    }
    PG8_WAIT_V(0);
    PG8_BAR;
#undef PG8_SA
#undef PG8_SB
#undef PG8_STAGE
#undef PG8_LDA
#undef PG8_LDB
#undef PG8_MMA
#undef PG8_WAIT_V
#undef PG8_WAIT_L
#undef PG8_BAR
#undef PG8_SCHED
}
}
using pg8::Unit; using pg8::Gemm; using pg8::StaticOrder;

__device__ __forceinline__ void rope8(f32x4& v0, f32x4& v1, const float* tab) {
    const f32x4 t0 = *(const f32x4*)tab, t1 = *(const f32x4*)(tab + 4);
    float a, b;
    a = v0.x * t0.x - v0.y * t0.y; b = v0.y * t0.x + v0.x * t0.y; v0.x = a; v0.y = b;
    a = v0.z * t0.z - v0.w * t0.w; b = v0.w * t0.z + v0.z * t0.w; v0.z = a; v0.w = b;
    a = v1.x * t1.x - v1.y * t1.y; b = v1.y * t1.x + v1.x * t1.y; v1.x = a; v1.y = b;
    a = v1.z * t1.z - v1.w * t1.w; b = v1.w * t1.z + v1.z * t1.w; v1.z = a; v1.w = b;
}
__device__ __forceinline__ u32x4 pack8(const f32x4 v0, const f32x4 v1) {
    u32x4 w; w.x = cvt_pk_bf16(v0.x, v0.y); w.y = cvt_pk_bf16(v0.z, v0.w); w.z = cvt_pk_bf16(v1.x, v1.y); w.w = cvt_pk_bf16(v1.z, v1.w); return w;
}
__device__ __forceinline__ void row_decode(int row, bool& lat, int& b, int& t, int& keyidx) {
    lat = row < ML;
    if (lat) { b = row >> 11; t = row & 2047; keyidx = CTXL + t; } else { const int r2 = row - ML; b = r2 >> 8; t = r2 & 255; keyidx = t; }
}
__device__ __forceinline__ void store_vt8(bf16_t* vt, int d0, int keyidx, const u32x4 w) {
    const int kp = (keyidx & ~31) | (((keyidx >> 2) & 3) << 3) | (((keyidx >> 4) & 1) << 2) | (keyidx & 3);
    bf16_t* p = vt + (size_t)d0 * NKEY + kp;
    p[0] = (bf16_t)(w.x & 0xffff); p[NKEY] = (bf16_t)(w.x >> 16); p[2 * NKEY] = (bf16_t)(w.y & 0xffff); p[3 * NKEY] = (bf16_t)(w.y >> 16);
    p[4 * NKEY] = (bf16_t)(w.z & 0xffff); p[5 * NKEY] = (bf16_t)(w.z >> 16); p[6 * NKEY] = (bf16_t)(w.w & 0xffff); p[7 * NKEY] = (bf16_t)(w.w >> 16);
}

struct EpiInProj {
    static constexpr bool PERM = true;
    unsigned char* wsb;
    __device__ __forceinline__ void operator()(const f32x4 (&acc)[2][2][4][2], const Unit& u, int wr, int wc, int fr, int fq) const {
        const int pn = u.pn, cw = wc * 32 + fq * 8;
        bf16_t* const U = (bf16_t*)(wsb + OFF_U); bf16_t* const QS = (bf16_t*)(wsb + OFF_QS); bf16_t* const KS = (bf16_t*)(wsb + OFF_KS); bf16_t* const VTS = (bf16_t*)(wsb + OFF_VTS);
        bf16_t* const CQ = (bf16_t*)(wsb + OFF_CQ); bf16_t* const CKV = (bf16_t*)(wsb + OFF_CKV); bf16_t* const KR = (bf16_t*)(wsb + OFF_KR);
        const float* const tswa = (const float*)(wsb + OFF_TSWA); const float* const tmla = (const float*)(wsb + OFF_TMLA);
#pragma unroll
        for (int ai = 0; ai < 2; ++ai)
#pragma unroll
            for (int m = 0; m < 4; ++m) {
                const int row = u.pm * 256 + ai * 128 + wr * 64 + m * 16 + fr;
                bool lat; int b, t, keyidx; row_decode(row, lat, b, t, keyidx);
#pragma unroll
                for (int bj = 0; bj < 2; ++bj) {
                    f32x4 v0 = acc[ai][bj][m][0], v1 = acc[ai][bj][m][1];
                    const int cl = bj * 128 + cw;
                    if (pn < 2) { const int cu = pn * 256 + cl; *(u32x4*)(U + (((size_t)(b * 32 + (cu >> 4)) * NKEY + keyidx) << 4) + (cu & 15)) = pack8(v0, v1); }
                    else if (pn < 5) { if (lat) rope8(v0, v1, tswa + ((size_t)t * 64 + (cw >> 1)) * 2); *(u32x4*)(QS + (size_t)row * 768 + (pn - 2) * 256 + cl) = pack8(v0, v1); }
                    else if (pn == 5) { if (lat) rope8(v0, v1, tswa + ((size_t)t * 64 + (cw >> 1)) * 2); *(u32x4*)(KS + ((size_t)(b * 2 + bj) * NKEY + keyidx) * 128 + cw) = pack8(v0, v1); }
                    else if (pn == 6) { store_vt8(VTS + (size_t)(b * 2 + bj) * 128 * NKEY, cw, keyidx, pack8(v0, v1)); }
                    else if (pn < 10) { *(u32x4*)(CQ + (size_t)row * 768 + (pn - 7) * 256 + cl) = pack8(v0, v1); }
                    else if (pn < 12) { *(u32x4*)(CKV + (size_t)row * 512 + (pn - 10) * 256 + cl) = pack8(v0, v1); }
                    else { if (bj == 0 && wc < 2) { if (lat) rope8(v0, v1, tmla + ((size_t)t * 32 + (cw >> 1)) * 2); *(u32x4*)(KR + ((size_t)b * NKEY + keyidx) * 64 + cw) = pack8(v0, v1); } }
                }
            }
    }
};
struct EpiUQ {
    static constexpr bool PERM = true;
    bf16_t* QM; const float *rs, *tmla;
    __device__ __forceinline__ void operator()(const f32x4 (&acc)[2][2][4][2], const Unit& u, int wr, int wc, int fr, int fq) const {
#pragma unroll
        for (int ai = 0; ai < 2; ++ai)
#pragma unroll
            for (int m = 0; m < 4; ++m) {
                const int row = u.pm * 256 + ai * 128 + wr * 64 + m * 16 + fr;
                const float r = rs[row]; const bool lat = row < ML; const int t = row & 2047;
#pragma unroll
                for (int bj = 0; bj < 2; ++bj) {
                    const int col = u.pn * 256 + bj * 128 + wc * 32 + fq * 8;
                    if (col < UQW) {
                        f32x4 v0 = acc[ai][bj][m][0] * r, v1 = acc[ai][bj][m][1] * r;
                        if (col >= 768 && lat) rope8(v0, v1, tmla + ((size_t)t * 32 + (((col - 768) & 63) >> 1)) * 2);
                        *(u32x4*)(QM + (size_t)row * UQW + col) = pack8(v0, v1);
                    }
                }
            }
    }
};
struct EpiUKV {
    static constexpr bool PERM = true;
    bf16_t *KN, *VTM; const float* rs;
    __device__ __forceinline__ void operator()(const f32x4 (&acc)[2][2][4][2], const Unit& u, int wr, int wc, int fr, int fq) const {
        const int h = u.pn, cw = wc * 32 + fq * 8;
#pragma unroll
        for (int ai = 0; ai < 2; ++ai)
#pragma unroll
            for (int m = 0; m < 4; ++m) {
                const int row = u.pm * 256 + ai * 128 + wr * 64 + m * 16 + fr;
                bool lat; int b, t, keyidx; row_decode(row, lat, b, t, keyidx);
                const float r = rs[row];
                *(u32x4*)(KN + ((size_t)(b * 6 + h) * NKEY + keyidx) * 128 + cw) = pack8(acc[ai][0][m][0] * r, acc[ai][0][m][1] * r);
                store_vt8(VTM + (size_t)(b * 6 + h) * 128 * NKEY, cw, keyidx, pack8(acc[ai][1][m][0] * r, acc[ai][1][m][1] * r));
            }
    }
};
struct EpiGLU {
    static constexpr bool PERM = true;
    const bf16_t* G; const float* bias; bf16_t* MIX;
    __device__ __forceinline__ void operator()(const f32x4 (&acc)[2][2][4][2], const Unit& u, int wr, int wc, int fr, int fq) const {
#pragma unroll
        for (int bj = 0; bj < 2; ++bj) {
            const int col = u.pn * 256 + bj * 128 + wc * 32 + fq * 8;
            const f32x4 b0 = *(const f32x4*)(bias + col), b1 = *(const f32x4*)(bias + col + 4);
#pragma unroll
            for (int ai = 0; ai < 2; ++ai)
#pragma unroll
                for (int m = 0; m < 4; ++m) {
                    const int row = u.pm * 256 + ai * 128 + wr * 64 + m * 16 + fr;
                    const u32x4 gw = *(const u32x4*)(G + (size_t)row * 512 + col);
                    const f32x4 z0 = acc[ai][bj][m][0] + b0, z1 = acc[ai][bj][m][1] + b1;
                    f32x4 o0, o1;
                    o0.x = bf_lo(gw.x) / (1.f + __expf(-z0.x)); o0.y = bf_hi(gw.x) / (1.f + __expf(-z0.y)); o0.z = bf_lo(gw.y) / (1.f + __expf(-z0.z)); o0.w = bf_hi(gw.y) / (1.f + __expf(-z0.w));
                    o1.x = bf_lo(gw.z) / (1.f + __expf(-z1.x)); o1.y = bf_hi(gw.z) / (1.f + __expf(-z1.y)); o1.z = bf_lo(gw.w) / (1.f + __expf(-z1.z)); o1.w = bf_hi(gw.w) / (1.f + __expf(-z1.w));
                    *(u32x4*)(MIX + (size_t)row * DM + col) = pack8(o0, o1);
                }
        }
    }
};
struct EpiBf16Out {
    static constexpr bool PERM = true;
    bf16_t* C; int ldc; size_t kc_stride;
    __device__ __forceinline__ void operator()(const f32x4 (&acc)[2][2][4][2], const Unit& u, int wr, int wc, int fr, int fq) const {
        const int row0 = u.pm * 256 + wr * 64 + fr, col0 = u.pn * 256 + wc * 32 + 8 * fq;
#pragma unroll
        for (int ai = 0; ai < 2; ++ai)
#pragma unroll
            for (int m = 0; m < 4; ++m) { bf16_t* rowp = C + (size_t)u.kc * kc_stride + (size_t)(row0 + ai * 128 + m * 16) * ldc + col0;
#pragma unroll
                for (int bj = 0; bj < 2; ++bj) *(u32x4*)(rowp + bj * 128) = pack8(acc[ai][bj][m][0], acc[ai][bj][m][1]); }
    }
};
struct EpiSqRelu {
    static constexpr bool PERM = true;
    bf16_t* O; int ldc;
    __device__ __forceinline__ void operator()(const f32x4 (&acc)[2][2][4][2], const Unit& u, int wr, int wc, int fr, int fq) const {
        const int row0 = u.pm * 256 + wr * 64 + fr, col0 = u.pn * 256 + wc * 32 + 8 * fq;
#pragma unroll
        for (int ai = 0; ai < 2; ++ai)
#pragma unroll
            for (int m = 0; m < 4; ++m) { bf16_t* rowp = O + (size_t)(row0 + ai * 128 + m * 16) * ldc + col0;
#pragma unroll
                for (int bj = 0; bj < 2; ++bj) {
                    f32x4 v0 = acc[ai][bj][m][0], v1 = acc[ai][bj][m][1];
#pragma unroll
                    for (int j = 0; j < 4; ++j) { const float a = fmaxf(v0[j], 0.f), b = fmaxf(v1[j], 0.f); v0[j] = a * a; v1[j] = b * b; }
                    *(u32x4*)(rowp + bj * 128) = pack8(v0, v1); } }
    }
};

__device__ __forceinline__ int src_col(int mode, int n) {
    if (mode == 1) {
        if (n >= 512 && n < 1536) { const int base = n & ~127, c = n & 127, half = c >> 6, cc = c & 63; return base + half * 64 + (cc >> 1) + 32 * (cc & 1); }
        if (n >= 3072) { const int c = n - 3072, half = c >> 5, cc = c & 31; return 3072 + half * 32 + (cc >> 1) + 16 * (cc & 1); }
        return n;
    }
    if (mode == 2) {
        if (n < 768) return (n >> 7) * 192 + (n & 127);
        const int r = n - 768, h = r >> 6, p = r & 63, half = p >> 5, cc = p & 31; return h * 192 + 128 + half * 32 + (cc >> 1) + 16 * (cc & 1);
    }
    return n;
}
__device__ __forceinline__ void transpose_item(const float* W, int K, int N, int nblk, bf16_t* WT, int mode, const float* kscale, LAS float* scr, int item, int lane) {
    const int kb = item / nblk, nb = item % nblk, k0 = 64 * kb, n0 = 32 * nb;
    const int sc = src_col(mode, n0 + (lane & 31));
    float wv[32];
#pragma unroll
    for (int i = 0; i < 32; ++i) wv[i] = W[(size_t)(k0 + 2 * i + (lane >> 5)) * N + sc];
    if (kscale) {
#pragma unroll
        for (int i = 0; i < 32; ++i) wv[i] *= kscale[k0 + 2 * i + (lane >> 5)];
    }
#pragma unroll
    for (int i = 0; i < 32; ++i) scr[(2 * i + (lane >> 5)) * 33 + (lane & 31)] = wv[i];
    LDS_WAIT();
    const int c = lane & 7;
#pragma unroll
    for (int j = 0; j < 4; ++j) { const int n = (lane >> 3) + 8 * j; const LAS float* s = scr + (8 * c) * 33 + n;
        u32x4 o; o.x = cvt_pk_bf16(s[0 * 33], s[1 * 33]); o.y = cvt_pk_bf16(s[2 * 33], s[3 * 33]); o.z = cvt_pk_bf16(s[4 * 33], s[5 * 33]); o.w = cvt_pk_bf16(s[6 * 33], s[7 * 33]);
        *(u32x4*)(WT + (size_t)(n0 + n) * K + k0 + 8 * c) = o; }
    LDS_WAIT();
}
__device__ __forceinline__ void ada_item(PP P, LAS unsigned char* lds, int item) {
    const int tid = otid(), layer = item / 96, col0 = (item % 96) * 128;
    LAS float* sv = (LAS float*)lds;
    LAS float* part = sv + 5 * 2048;
    for (int i = tid; i < 5 * 2048; i += 512) { const int v = i >> 11, k = i & 2047; const float c = v < 4 ? P->in[1][v * 2048 + k] : P->in[3][k]; sv[i] = c / (1.f + expf(-c)); }
    __syncthreads();
    const int cgp = tid & 31, ks = tid >> 5;
    float acc[5][4];
#pragma unroll
    for (int v = 0; v < 5; ++v)
#pragma unroll
        for (int j = 0; j < 4; ++j) acc[v][j] = 0.f;
    const float* wp = P->in[4] + (size_t)layer * 2048 * 12288 + (size_t)(ks * 128) * 12288 + col0 + 4 * cgp;
#pragma unroll 8
    for (int k = 0; k < 128; ++k) {
        const f32x4 w = *(const f32x4*)(wp + (size_t)k * 12288);
#pragma unroll
        for (int v = 0; v < 5; ++v) { const float s = sv[v * 2048 + ks * 128 + k]; acc[v][0] += s * w.x; acc[v][1] += s * w.y; acc[v][2] += s * w.z; acc[v][3] += s * w.w; }
    }
#pragma unroll
    for (int v = 0; v < 5; ++v)
#pragma unroll
        for (int j = 0; j < 4; ++j) part[(ks * 5 + v) * 128 + 4 * cgp + j] = acc[v][j];
    __syncthreads();
    float* mods = (float*)(lws(P->ws) + OFF_MODS);
    for (int o = tid; o < 640; o += 512) { const int v = o >> 7, cc = o & 127; float s = P->in[5][layer * 12288 + col0 + cc];
#pragma unroll
        for (int q = 0; q < 16; ++q) s += part[(q * 5 + v) * 128 + cc];
        mods[(size_t)(layer * 5 + v) * 12288 + col0 + cc] = s; }
    __syncthreads();
}
__device__ __forceinline__ void phase_prep(PP P, LAS unsigned char* lds, int G) {
    const int tid = otid(), wid = tid >> 6, lane = tid & 63, bid = obid();
    for (int it = bid; it < 192; it += G) ada_item(P, lds, it);
    { float* tswa = (float*)(lws(P->ws) + OFF_TSWA); float* tmla = (float*)(lws(P->ws) + OFF_TMLA);
      for (int i = bid * 512 + tid; i < 2048 * 64; i += G * 512) { const int t = i >> 6, pi = i & 63, j = pi & 31; const float inv = exp2f(-(float)j * (13.287712379549449f / 32.f));
          const float ang = (float)(pi < 32 ? (t >> 6) : (t & 63)) * inv; tswa[2 * i] = cosf(ang); tswa[2 * i + 1] = sinf(ang); }
      for (int i = bid * 512 + tid; i < 2048 * 32; i += G * 512) { const int t = i >> 5, pi = i & 31, j = pi & 15; const float inv = exp2f(-(float)j * (13.287712379549449f / 16.f));
          const float ang = (float)(pi < 16 ? (t >> 6) : (t & 63)) * inv; tmla[2 * i] = cosf(ang); tmla[2 * i + 1] = sinf(ang); } }
    LAS float* scr = (LAS float*)(lds + wid * 8704);
    const int gw = bid * NWAVES + wid, NGW = G * NWAVES;
    constexpr int I_IN = 32 * 98, I_OUT = 32 * 64, I_UQ = 12 * 36, I_UKV = 8 * 48, I_GLU = 8 * 16, I_1 = 32 * 256, I_2 = 128 * 64;
    constexpr int I_L = I_IN + I_OUT + I_UQ + I_UKV + I_GLU + I_1 + I_2;
    auto do_item = [&](int it) {
        const int layer = it / I_L; int r = it % I_L;
        unsigned char* wl = lws(P->ws) + (size_t)layer * WL_STRIDE;
        if (r < I_IN) { transpose_item(P->in[10] + (size_t)layer * DM * INW, DM, INW, 98, (bf16_t*)(wl + OFF_WIN), 1, nullptr, scr, r, lane); return; } r -= I_IN;
        if (r < I_OUT) { transpose_item(P->in[11] + (size_t)layer * DM * DM, DM, DM, 64, (bf16_t*)(wl + OFF_WOUT), 0, nullptr, scr, r, lane); return; } r -= I_OUT;
        if (r < I_UQ) { transpose_item(P->in[24] + (size_t)layer * 768 * UQW, 768, UQW, 36, (bf16_t*)(wl + OFF_WUQ), 2, P->in[23] + layer * 768, scr, r, lane); return; } r -= I_UQ;
        if (r < I_UKV) { transpose_item(P->in[26] + (size_t)layer * 512 * UKVW, 512, UKVW, 48, (bf16_t*)(wl + OFF_WUKV), 0, P->in[25] + layer * 512, scr, r, lane); return; } r -= I_UKV;
        if (r < I_GLU) { transpose_item(P->in[20] + (size_t)layer * 512 * 512, 512, 512, 16, (bf16_t*)(wl + OFF_WGLU), 0, nullptr, scr, r, lane); return; } r -= I_GLU;
        if (r < I_1) { transpose_item(P->in[27] + (size_t)layer * DM * DFF, DM, DFF, 256, (bf16_t*)(wl + OFF_W1), 0, nullptr, scr, r, lane); return; } r -= I_1;
        transpose_item(P->in[28] + (size_t)layer * DFF * DM, DFF, DM, 64, (bf16_t*)(wl + OFF_W2), 0, nullptr, scr, r, lane);
    };
    if (G == 256) {
        const int kmax = bid < 192 ? 18 : 22;
        for (int k = 0; k < kmax; ++k) { const int it = gw + k * NGW; if (it < 2 * I_L) do_item(it); }
        if (bid >= 192) { const int w2 = gw - 1536;
            for (int m = 0; m < 12; ++m) { const int j = w2 + m * 512, it = (j % 1536) + (18 + j / 1536) * NGW; if (it < 2 * I_L) do_item(it); } }
    } else {
        for (int it = gw; it < 2 * I_L; it += NGW) do_item(it);
    }
}

struct RowArgs { const void* xin; bool xin_bf; void* xout; bool xout_bf; const bf16_t* o; int nparts; const float* gate; const float* gpost; const float* gpre; const float* shift; const float* scale; bf16_t* hout; };
struct RowParams { f32x4 gg[8], ga[8], sh[8]; };
__device__ __forceinline__ void row_params(const RowArgs& a, int lane, RowParams& p) {
#pragma unroll
    for (int j = 0; j < 8; ++j) { const int d = 4 * (lane + 64 * j);
        if (a.o) p.gg[j] = *(const f32x4*)(a.gate + d) * *(const f32x4*)(a.gpost + d);
        if (a.hout) { p.ga[j] = *(const f32x4*)(a.gpre + d) * (*(const f32x4*)(a.scale + d) + 1.f); p.sh[j] = *(const f32x4*)(a.shift + d); } }
}
template <int NR, bool SH>
__device__ __forceinline__ void row_stage(const RowArgs (&A)[NR], int lane, const RowParams& PR) {
    f32x4 v[NR][8], ov[NR][8];
#pragma unroll
    for (int r = 0; r < NR; ++r)
#pragma unroll
        for (int j = 0; j < 8; ++j) {
            if (A[r].xin_bf) { const u32x2 w = *(const u32x2*)((const bf16_t*)A[r].xin + 4 * (lane + 64 * j)); v[r][j] = (f32x4){bf_lo(w.x), bf_hi(w.x), bf_lo(w.y), bf_hi(w.y)}; }
            else v[r][j] = *(const f32x4*)((const float*)A[r].xin + 4 * (lane + 64 * j)); }
    if (A[0].o) {
#pragma unroll
        for (int r = 0; r < NR; ++r) {
#pragma unroll
            for (int j = 0; j < 8; ++j) { const u32x2 w = *(const u32x2*)(A[r].o + 4 * (lane + 64 * j)); ov[r][j] = (f32x4){bf_lo(w.x), bf_hi(w.x), bf_lo(w.y), bf_hi(w.y)}; }
            if (A[r].nparts == 8) {
#pragma unroll
                for (int j = 0; j < 8; ++j) { u32x2 w2[7];
#pragma unroll
                    for (int pp = 0; pp < 7; ++pp) w2[pp] = *(const u32x2*)(A[r].o + (size_t)(pp + 1) * MC * DM + 4 * (lane + 64 * j));
#pragma unroll
                    for (int pp = 0; pp < 7; ++pp) ov[r][j] += (f32x4){bf_lo(w2[pp].x), bf_hi(w2[pp].x), bf_lo(w2[pp].y), bf_hi(w2[pp].y)}; }
            }
        }
        float rstd[NR];
#pragma unroll
        for (int r = 0; r < NR; ++r) { float ss = 0.f;
#pragma unroll
            for (int j = 0; j < 8; ++j) ss += ov[r][j].x * ov[r][j].x + ov[r][j].y * ov[r][j].y + ov[r][j].z * ov[r][j].z + ov[r][j].w * ov[r][j].w;
            rstd[r] = rsqrtf(wave_sum(ss) * (1.f / DM) + EPSN); }
#pragma unroll
        for (int j = 0; j < 8; ++j) {
            f32x4 gg[NR];
#pragma unroll
            for (int r = 0; r < NR; ++r) if (!SH) gg[r] = *(const f32x4*)(A[r].gate + 4 * (lane + 64 * j)) * *(const f32x4*)(A[r].gpost + 4 * (lane + 64 * j));
#pragma unroll
            for (int r = 0; r < NR; ++r) v[r][j] += (SH ? PR.gg[j] : gg[r]) * (ov[r][j] * rstd[r]);
        }
    }
    if (A[0].xout) {
#pragma unroll
        for (int r = 0; r < NR; ++r)
#pragma unroll
            for (int j = 0; j < 8; ++j) {
                if (A[r].xout_bf) { u32x2 w; w.x = cvt_pk_bf16(v[r][j].x, v[r][j].y); w.y = cvt_pk_bf16(v[r][j].z, v[r][j].w); *(u32x2*)((bf16_t*)A[r].xout + 4 * (lane + 64 * j)) = w; }
                else *(f32x4*)((float*)A[r].xout + 4 * (lane + 64 * j)) = v[r][j]; }
    }
    if (A[0].hout) {
        float rstd[NR];
#pragma unroll
        for (int r = 0; r < NR; ++r) { float ss = 0.f;
#pragma unroll
            for (int j = 0; j < 8; ++j) ss += v[r][j].x * v[r][j].x + v[r][j].y * v[r][j].y + v[r][j].z * v[r][j].z + v[r][j].w * v[r][j].w;
            rstd[r] = rsqrtf(wave_sum(ss) * (1.f / DM) + EPSN); }
#pragma unroll
        for (int j = 0; j < 8; ++j) { const int d = 4 * (lane + 64 * j);
            f32x4 ga[NR], sh[NR];
#pragma unroll
            for (int r = 0; r < NR; ++r) if (!SH) { ga[r] = *(const f32x4*)(A[r].gpre + d) * (*(const f32x4*)(A[r].scale + d) + 1.f); sh[r] = *(const f32x4*)(A[r].shift + d); }
#pragma unroll
            for (int r = 0; r < NR; ++r) { const f32x4 h = v[r][j] * rstd[r] * (SH ? PR.ga[j] : ga[r]) + (SH ? PR.sh[j] : sh[r]);
                u32x2 w; w.x = cvt_pk_bf16(h.x, h.y); w.y = cvt_pk_bf16(h.z, h.w); *(u32x2*)(A[r].hout + d) = w; }
        }
    }
}
__device__ __forceinline__ RowArgs row_args(PP P, int stage, int layer, int row) {
    const float* mods = (const float*)(lws(P->ws) + OFF_MODS);
    bf16_t* XS = (bf16_t*)(lws(P->ws) + OFF_XS); bf16_t* H = (bf16_t*)(lws(P->ws) + OFF_H); const bf16_t* O = (const bf16_t*)(lws(P->ws) + OFF_O); const bf16_t* OP = (const bf16_t*)(lws(P->ws) + OFF_OPART);
    const int v = row < ML ? (row >> 11) : 4;
    const float* xorig = row < ML ? P->in[0] + (size_t)row * DM : P->in[2] + (size_t)(row - ML) * DM;
    const float* md = mods + (size_t)(layer * 5 + v) * 12288;
    const bf16_t* orow = row < ML ? O + (size_t)row * DM : OP + (size_t)(row - ML) * DM; const int np = row < ML ? 1 : 8;
    RowArgs a;
    bf16_t* xs = XS + (size_t)row * DM; bf16_t* hrow = H + (size_t)row * DM;
    if (stage == 0) a = RowArgs{xorig, false, nullptr, false, nullptr, 1, nullptr, nullptr, P->in[6], md, md + DM, hrow};
    else if (stage == 1) { if (layer == 0) a = RowArgs{xorig, false, xs, true, orow, np, md + 2 * DM, P->in[7], P->in[8], md + 3 * DM, md + 4 * DM, hrow};
                           else a = RowArgs{xs, true, xs, true, orow, np, md + 2 * DM, P->in[7] + DM, P->in[8] + DM, md + 3 * DM, md + 4 * DM, hrow}; }
    else if (layer == 0) { const float* md1 = mods + (size_t)(5 + v) * 12288;
        a = RowArgs{xs, true, xs, true, orow, np, md + 5 * DM, P->in[9], P->in[6] + DM, md1, md1 + DM, hrow}; }
    else a = RowArgs{xs, true, P->out + (size_t)row * DM, false, orow, np, md + 5 * DM, P->in[9] + DM, nullptr, nullptr, nullptr, nullptr};
    return a;
}
__device__ __forceinline__ void phase_rows(PP P, int stage, int layer, int G) {
    const int tid = otid(), wid = tid >> 6, lane = tid & 63;
    const int NW = G * NWAVES, gw = obid() * NWAVES + wid;
#pragma unroll 1
    for (int row0 = 4 * gw; row0 < ML; row0 += 4 * NW) {
        RowParams PR; row_params(row_args(P, stage, layer, row0), lane, PR);
#pragma unroll 1
        for (int row = row0; row < row0 + 4; ++row) { const RowArgs A[1] = {row_args(P, stage, layer, row)}; row_stage<1, true>(A, lane, PR); } }
    if (stage == 0 || layer == 0) {
#pragma unroll 1
        for (int row = ML + gw; row < MT; row += NW) { const RowArgs A[1] = {row_args(P, stage, layer, row)}; RowParams PR; row_stage<1, false>(A, lane, PR); }
    }
}

__device__ __forceinline__ int s5_row(int b, int dir, int s) {
    if (dir == 0) return s < CTXL ? ML + b * CTXL + s : b * SEQ + (s - CTXL);
    return s < CTXL ? ML + b * CTXL + (CTXL - 1 - s) : b * SEQ + (SEQ - 1 - (s - CTXL));
}
__device__ __forceinline__ int s5_key(int dir, int s) { return dir == 0 ? s : (s < CTXL ? CTXL - 1 - s : CTXL + SEQ - 1 - (s - CTXL)); }
__device__ __forceinline__ void s5_lam(PP P, int pidx, int n, float dt, float& lr, float& li, float& fr, float& fi) {
    const float are = P->in[12][pidx * 64 + n], aim = P->in[13][pidx * 64 + n];
    const float mag = expf(are * dt); lr = mag * cosf(aim * dt); li = mag * sinf(aim * dt);
    const float den = are * are + aim * aim, nr = lr - 1.f;
    fr = (nr * are + li * aim) / den; fi = (li * are - nr * aim) / den;
}
__device__ __forceinline__ void s5_unit(PP P, LAS unsigned char* lds, int layer, int unit) {
    const int tid = otid(), wid = tid >> 6, lane = tid & 63, c = lane & 15, g = lane >> 4;
    const int b = unit >> 6, grp = (unit >> 1) & 31, dir = unit & 1;
    const int pidx = (layer * 2 + dir) * 32 + grp;
    const bf16_t* Ug = (const bf16_t*)(lws(P->ws) + OFF_U) + (size_t)(b * 32 + grp) * NKEY * 16;
    float* YD = (float*)(lws(P->ws) + OFF_YDIR) + (size_t)dir * MT * 512;
    LAS float* ends = (LAS float*)lds;
    const float dt = expf(P->in[14][pidx]);
    LAS float* lamt = (LAS float*)(lds + 65536);
    if (tid < 64) { float a0, a1, a2, a3; s5_lam(P, pidx, tid, dt, a0, a1, a2, a3); *(LAS f32x4*)(lamt + 4 * tid) = (f32x4){a0, a1, a2, a3}; }
    __syncthreads();
    f32x4 lr[4], li[4];
#pragma unroll
    for (int t4 = 0; t4 < 4; ++t4)
#pragma unroll
        for (int r = 0; r < 4; ++r) { const f32x4 q = *(const LAS f32x4*)(lamt + 4 * (16 * t4 + 4 * g + r)); lr[t4][r] = q.x; li[t4][r] = q.y; }
    bf16x8 bfr[8];
#pragma unroll
    for (int t4 = 0; t4 < 4; ++t4) {
        const int n = 16 * t4 + c; const f32x4 q = *(const LAS f32x4*)(lamt + 4 * n); const float fr = q.z, fi = q.w;
        u32x4 wr = (u32x4){0u, 0u, 0u, 0u}, wi = (u32x4){0u, 0u, 0u, 0u};
        if (g < 2) {
            const float* bre = P->in[15] + ((size_t)pidx * 64 + n) * 16 + 8 * g; const float* bim = P->in[16] + ((size_t)pidx * 64 + n) * 16 + 8 * g;
            const f32x4 r0 = *(const f32x4*)bre, r1 = *(const f32x4*)(bre + 4), i0 = *(const f32x4*)bim, i1 = *(const f32x4*)(bim + 4);
            const f32x4 ar0 = r0 * fr - i0 * fi, ar1 = r1 * fr - i1 * fi, ai0 = i0 * fr + r0 * fi, ai1 = i1 * fr + r1 * fi;
            wr = pack8(ar0, ar1); wi = pack8(ai0, ai1);
        }
        bfr[t4] = __builtin_bit_cast(bf16x8, wr); bfr[4 + t4] = __builtin_bit_cast(bf16x8, wi);
    }
    bf16x8 cfr[4];
#pragma unroll
    for (int f = 0; f < 4; ++f) {
        const float* cp = (f < 2 ? P->in[17] : P->in[18]) + ((size_t)pidx * 16 + c) * 64 + 32 * (f & 1) + 4 * g;
        f32x4 a = *(const f32x4*)cp, bq = *(const f32x4*)(cp + 16);
        if (f >= 2) { a = -a; bq = -bq; }
        cfr[f] = __builtin_bit_cast(bf16x8, pack8(a, bq));
    }
    const int seg = wid * 16 + c, s0 = 18 * seg;
    f32x4 hr[4], hi[4];
#pragma unroll
    for (int t4 = 0; t4 < 4; ++t4)
#pragma unroll
        for (int r = 0; r < 4; ++r) { hr[t4][r] = 0.f; hi[t4][r] = 0.f; }
    const f32x4 zero4 = (f32x4){0.f, 0.f, 0.f, 0.f};
#pragma unroll 3
    for (int t = 0; t < 18; ++t) {
        u32x4 uw = (u32x4){0u, 0u, 0u, 0u};
        if (g < 2) uw = *(const u32x4*)(Ug + (size_t)s5_key(dir, s0 + t) * 16 + 8 * g);
        const bf16x8 uf = __builtin_bit_cast(bf16x8, uw);
#pragma unroll
        for (int t4 = 0; t4 < 4; ++t4) {
            const f32x4 cr = lr[t4] * hr[t4] - li[t4] * hi[t4], ci = lr[t4] * hi[t4] + li[t4] * hr[t4];
            hr[t4] = __builtin_amdgcn_mfma_f32_16x16x32_bf16(bfr[t4], uf, cr, 0, 0, 0);
            hi[t4] = __builtin_amdgcn_mfma_f32_16x16x32_bf16(bfr[4 + t4], uf, ci, 0, 0, 0); }
    }
#pragma unroll
    for (int t4 = 0; t4 < 4; ++t4) {
        *(LAS f32x4*)(ends + seg * 128 + 16 * t4 + 4 * g) = hr[t4];
        *(LAS f32x4*)(ends + seg * 128 + 64 + 16 * t4 + 4 * g) = hi[t4];
    }
    __syncthreads();
    if (wid == 0) {
        const f32x4 q = *(const LAS f32x4*)(lamt + 4 * lane); const float l0 = q.x, l1 = q.y;
        float p2r = l0 * l0 - l1 * l1, p2i = 2.f * l0 * l1, qr = p2r, qi = p2i;
#pragma unroll
        for (int i = 0; i < 3; ++i) { const float a = qr * qr - qi * qi, d = 2.f * qr * qi; qr = a; qi = d; }
        const float Lr = qr * p2r - qi * p2i, Li = qr * p2i + qi * p2r;
        float ir = 0.f, ii = 0.f;
#pragma unroll 4
        for (int j = 0; j < 128; ++j) { const float er = ends[j * 128 + lane], ei = ends[j * 128 + 64 + lane];
            ends[j * 128 + lane] = ir; ends[j * 128 + 64 + lane] = ii;
            const float a = Lr * ir - Li * ii + er, d = Lr * ii + Li * ir + ei; ir = a; ii = d; }
    }
    __syncthreads();
#pragma unroll
    for (int t4 = 0; t4 < 4; ++t4) {
        const f32x4 a = *(const LAS f32x4*)(ends + seg * 128 + 16 * t4 + 4 * g), d = *(const LAS f32x4*)(ends + seg * 128 + 64 + 16 * t4 + 4 * g);
#pragma unroll
        for (int r = 0; r < 4; ++r) { hr[t4][r] = a[r]; hi[t4][r] = d[r]; }
    }
#pragma unroll 3
    for (int t = 0; t < 18; ++t) {
        const int row = s5_row(b, dir, s0 + t);
        u32x4 uw = (u32x4){0u, 0u, 0u, 0u};
        if (g < 2) uw = *(const u32x4*)(Ug + (size_t)s5_key(dir, s0 + t) * 16 + 8 * g);
        const bf16x8 uf = __builtin_bit_cast(bf16x8, uw);
#pragma unroll
        for (int t4 = 0; t4 < 4; ++t4) {
            const f32x4 cr = lr[t4] * hr[t4] - li[t4] * hi[t4], ci = lr[t4] * hi[t4] + li[t4] * hr[t4];
            hr[t4] = __builtin_amdgcn_mfma_f32_16x16x32_bf16(bfr[t4], uf, cr, 0, 0, 0);
            hi[t4] = __builtin_amdgcn_mfma_f32_16x16x32_bf16(bfr[4 + t4], uf, ci, 0, 0, 0); }
        f32x4 y = zero4;
#pragma unroll
        for (int f = 0; f < 4; ++f) {
            const int ta = 2 * (f & 1), tb = ta + 1;
            u32x4 w;
            if (f < 2) { w.x = cvt_pk_bf16(hr[ta][0], hr[ta][1]); w.y = cvt_pk_bf16(hr[ta][2], hr[ta][3]); w.z = cvt_pk_bf16(hr[tb][0], hr[tb][1]); w.w = cvt_pk_bf16(hr[tb][2], hr[tb][3]); }
            else       { w.x = cvt_pk_bf16(hi[ta][0], hi[ta][1]); w.y = cvt_pk_bf16(hi[ta][2], hi[ta][3]); w.z = cvt_pk_bf16(hi[tb][0], hi[tb][1]); w.w = cvt_pk_bf16(hi[tb][2], hi[tb][3]); }
            y = __builtin_amdgcn_mfma_f32_16x16x32_bf16(cfr[f], __builtin_bit_cast(bf16x8, w), y, 0, 0, 0);
        }
        *(f32x4*)(YD + (size_t)row * 512 + grp * 16 + 4 * g) = y;
    }
    __syncthreads();
}
__device__ __forceinline__ void phase_s5(PP P, LAS unsigned char* lds, int layer, int G) {
    for (int u = obid(); u < 256; u += G) s5_unit(P, lds, layer, u);
    const int tid = otid(), wid = tid >> 6, lane = tid & 63;
    const bf16_t* CQ = (const bf16_t*)(lws(P->ws) + OFF_CQ); const bf16_t* CKV = (const bf16_t*)(lws(P->ws) + OFF_CKV);
    float* RSQ = (float*)(lws(P->ws) + OFF_RSQ); float* RSKV = (float*)(lws(P->ws) + OFF_RSKV);
    for (int row = obid() * NWAVES + wid; row < MT; row += G * NWAVES) {
        float s = 0.f;
#pragma unroll
        for (int j = 0; j < 3; ++j) { const u32x2 w = *(const u32x2*)(CQ + (size_t)row * 768 + 4 * (lane + 64 * j)); const float a = bf_lo(w.x), b = bf_hi(w.x), c = bf_lo(w.y), d = bf_hi(w.y); s += a * a + b * b + c * c + d * d; }
        s = wave_sum(s);
        float s2 = 0.f;
        { const u32x4 w = *(const u32x4*)(CKV + (size_t)row * 512 + 8 * lane);
          float a;
          a = bf_lo(w.x); s2 += a * a; a = bf_hi(w.x); s2 += a * a; a = bf_lo(w.y); s2 += a * a; a = bf_hi(w.y); s2 += a * a;
          a = bf_lo(w.z); s2 += a * a; a = bf_hi(w.z); s2 += a * a; a = bf_lo(w.w); s2 += a * a; a = bf_hi(w.w); s2 += a * a; }
        s2 = wave_sum(s2);
        if (lane == 0) { RSQ[row] = rsqrtf(s * (1.f / 768.f) + EPSN); RSKV[row] = rsqrtf(s2 * (1.f / 512.f) + EPSN); }
    }
}
__device__ __forceinline__ void phase_ycombine(PP P, int layer, int G) {
    const bf16_t* U = (const bf16_t*)(lws(P->ws) + OFF_U); const float* YD = (const float*)(lws(P->ws) + OFF_YDIR); bf16_t* Gb = (bf16_t*)(lws(P->ws) + OFF_G);
    const float* dsk = P->in[19] + layer * 512;
    for (int i = obid() * 512 + otid(); i < MT * 128; i += G * 512) {
        const int row = i >> 7, c = (i & 127) * 4;
        bool lat; int bb, tt, kidx; row_decode(row, lat, bb, tt, kidx);
        const u32x2 w = *(const u32x2*)(U + (((size_t)(bb * 32 + (c >> 4)) * NKEY + kidx) << 4) + (c & 15));
        const f32x4 yf = *(const f32x4*)(YD + (size_t)row * 512 + c), yb = *(const f32x4*)(YD + (size_t)(MT + row) * 512 + c), d = *(const f32x4*)(dsk + c);
        f32x4 y = (f32x4){bf_lo(w.x), bf_hi(w.x), bf_lo(w.y), bf_hi(w.y)} * d + yf + yb;
#pragma unroll
        for (int e = 0; e < 4; ++e) { const float x = y[e], z = 0.7978845608028654f * (x + 0.044715f * x * x * x); const float th = 1.f - 2.f / (1.f + __expf(2.f * z)); y[e] = 0.5f * x * (1.f + th); }
        u32x2 o; o.x = cvt_pk_bf16(y.x, y.y); o.y = cvt_pk_bf16(y.z, y.w); *(u32x2*)(Gb + (size_t)row * 512 + c) = o;
    }
}

template <int NKR>
__device__ __forceinline__ void attn_block(LAS unsigned char* lds,
                                           const bf16_t* qa, int qa_stride, const bf16_t* qb, int qb_stride,
                                           const bf16_t* ka, const bf16_t* kb, const bf16_t* vt,
                                           int n0, int k1_beg, int n1, int qpos0,
                                           float cscale, float m_init, float l_init, bf16_t* out, int out_stride) {
    constexpr int KROWB = (128 + 32 * NKR) * 2 + 32, VROWB = 160,   VOFF = 64 * KROWB, BUFB = VOFF + 128 * VROWB;
    const int tid = otid(), wid = __builtin_amdgcn_readfirstlane(tid >> 6), lane = tid & 63, fr = lane & 15, g = lane >> 4;
    const int nt = n0 + n1;
    bf16x8 qf[2][4 + NKR];
#pragma unroll
    for (int qt = 0; qt < 2; ++qt) {
#pragma unroll
        for (int ks = 0; ks < 4; ++ks) qf[qt][ks] = *(const bf16x8*)(qa + (size_t)(wid * 32 + qt * 16 + fr) * qa_stride + ks * 32 + 8 * g);
#pragma unroll
        for (int ks = 0; ks < NKR; ++ks) qf[qt][4 + ks] = *(const bf16x8*)(qb + (size_t)(wid * 32 + qt * 16 + fr) * qb_stride + ks * 32 + 8 * g);
    }
    f32x4 oacc[8][2];
#pragma unroll
    for (int dt = 0; dt < 8; ++dt) { oacc[dt][0] = (f32x4){0.f, 0.f, 0.f, 0.f}; oacc[dt][1] = (f32x4){0.f, 0.f, 0.f, 0.f}; }
    float mrun[2] = {m_init, m_init}, lrun[2] = {g == 0 ? l_init : 0.f, g == 0 ? l_init : 0.f};
    u32x4 sk[2], sr, sv[2];
    const int krow = tid >> 4, kcc = tid & 15, rrow = tid >> 3, rcc = tid & 7;
#define ATT_LOADK(kb0) do { \
        sk[0] = *(const u32x4*)(ka + (size_t)((kb0) + krow) * 128 + kcc * 8); sk[1] = *(const u32x4*)(ka + (size_t)((kb0) + 32 + krow) * 128 + kcc * 8); \
        if (NKR) sr = *(const u32x4*)(kb + (size_t)((kb0) + rrow) * 64 + rcc * 8); } while (0)
#define ATT_STOREK(buf) do { LAS unsigned char* _b = lds + (buf) * BUFB; \
        *(LAS u32x4*)(_b + krow * KROWB + kcc * 16) = sk[0]; *(LAS u32x4*)(_b + (32 + krow) * KROWB + kcc * 16) = sk[1]; \
        if (NKR) *(LAS u32x4*)(_b + rrow * KROWB + 256 + rcc * 16) = sr; } while (0)
#define ATT_LOADV(kb0) do { \
        sv[0] = *(const u32x4*)(vt + (size_t)rrow * NKEY + (kb0) + rcc * 8); sv[1] = *(const u32x4*)(vt + (size_t)(64 + rrow) * NKEY + (kb0) + rcc * 8); } while (0)
#define ATT_STOREV(buf) do { LAS unsigned char* _b = lds + (buf) * BUFB; \
        *(LAS u32x4*)(_b + VOFF + rrow * VROWB + rcc * 16) = sv[0]; *(LAS u32x4*)(_b + VOFF + (64 + rrow) * VROWB + rcc * 16) = sv[1]; } while (0)
    { const int k00 = n0 > 0 ? 0 : k1_beg; ATT_LOADK(k00); ATT_STOREK(0); ATT_LOADV(k00); ATT_STOREV(0); }
    __syncthreads();
#pragma unroll 1
    for (int i = 0; i < nt; ++i) {
        const int kbase = i < n0 ? 64 * i : k1_beg + 64 * (i - n0);
        const bool msk = i >= n0;
        const int kn = (i + 1) < n0 ? 64 * (i + 1) : k1_beg + 64 * (i + 1 - n0);
        bool active = true;
        if (msk) { const int kp = kbase - CTXL, qw = qpos0 + 32 * wid; active = (kp < qw + 160) && (kp + 64 > qw - 128); }
        const LAS unsigned char* kbuf = lds + (i & 1) * BUFB; const LAS unsigned char* vbuf = kbuf + VOFF;
        f32x4 st[4][2];
        if (active) {
#pragma unroll
            for (int kt = 0; kt < 4; ++kt) { st[kt][0] = (f32x4){0.f, 0.f, 0.f, 0.f}; st[kt][1] = (f32x4){0.f, 0.f, 0.f, 0.f}; }
            bf16x8 kf[2][4];
#pragma unroll
            for (int kt = 0; kt < 4; ++kt) kf[0][kt] = *(const LAS bf16x8*)(kbuf + (kt * 16 + fr) * KROWB + g * 16);
#pragma unroll
            for (int ks = 0; ks < 4 + NKR; ++ks) {
                if (ks + 1 < 4 + NKR) {
#pragma unroll
                    for (int kt = 0; kt < 4; ++kt) kf[(ks + 1) & 1][kt] = *(const LAS bf16x8*)(kbuf + (kt * 16 + fr) * KROWB + (ks + 1) * 64 + g * 16);
                }
#pragma unroll
                for (int kt = 0; kt < 4; ++kt) {
                    st[kt][0] = __builtin_amdgcn_mfma_f32_16x16x32_bf16(kf[ks & 1][kt], qf[0][ks], st[kt][0], 0, 0, 0);
                    st[kt][1] = __builtin_amdgcn_mfma_f32_16x16x32_bf16(kf[ks & 1][kt], qf[1][ks], st[kt][1], 0, 0, 0); }
                __builtin_amdgcn_sched_barrier(0);
            }
        }
        if (i + 1 < nt) { ATT_LOADK(kn); ATT_LOADV(kn); }
        if (active) {
            bf16x8 pb[2][2];
#pragma unroll
            for (int qt = 0; qt < 2; ++qt) {
                float tv[4][4]; float mxr = -3.0e38f;
#pragma unroll
                for (int kt = 0; kt < 4; ++kt)
#pragma unroll
                    for (int r = 0; r < 4; ++r) { float t = st[kt][qt][r];
                        if (msk) { const int kpos = kbase + kt * 16 + 4 * g + r - CTXL, qpos = qpos0 + wid * 32 + qt * 16 + fr; const int dlt = qpos - kpos; if (dlt > 128 || dlt < -128) t = -1e30f; }
                        tv[kt][r] = t; mxr = fmaxf(mxr, t); }
                mxr = fmaxf(mxr, __shfl_xor(mxr, 16)); mxr = fmaxf(mxr, __shfl_xor(mxr, 32));
                const float mxs = mxr * cscale;
                float mx = mrun[qt], alpha = 1.f;
                if (__any(mxs > mrun[qt] + 8.f)) {
                    mx = fmaxf(mrun[qt], mxs); alpha = __builtin_amdgcn_exp2f(mrun[qt] - mx); mrun[qt] = mx;
#pragma unroll
                    for (int dt = 0; dt < 8; ++dt) oacc[dt][qt] *= alpha;
                }
                float ps = 0.f;
#pragma unroll
                for (int kt = 0; kt < 4; ++kt)
#pragma unroll
                    for (int r = 0; r < 4; ++r) { tv[kt][r] = __builtin_amdgcn_exp2f(__builtin_fmaf(tv[kt][r], cscale, -mx)); ps += tv[kt][r]; }
                lrun[qt] = lrun[qt] * alpha + ps;
#pragma unroll
                for (int G2 = 0; G2 < 2; ++G2) { u32x4 w; w.x = cvt_pk_bf16(tv[2 * G2][0], tv[2 * G2][1]); w.y = cvt_pk_bf16(tv[2 * G2][2], tv[2 * G2][3]);
                    w.z = cvt_pk_bf16(tv[2 * G2 + 1][0], tv[2 * G2 + 1][1]); w.w = cvt_pk_bf16(tv[2 * G2 + 1][2], tv[2 * G2 + 1][3]); pb[qt][G2] = __builtin_bit_cast(bf16x8, w); }
            }
            __builtin_amdgcn_sched_barrier(0);
            bf16x8 vf[2][2];
#pragma unroll
            for (int q = 0; q < 2; ++q) vf[0][q] = *(const LAS bf16x8*)(vbuf + fr * VROWB + q * 64 + g * 16);
#pragma unroll
            for (int dt = 0; dt < 8; ++dt) {
                if (dt + 1 < 8) {
#pragma unroll
                    for (int q = 0; q < 2; ++q) vf[(dt + 1) & 1][q] = *(const LAS bf16x8*)(vbuf + ((dt + 1) * 16 + fr) * VROWB + q * 64 + g * 16);
                }
#pragma unroll
                for (int q = 0; q < 2; ++q) {
                    oacc[dt][0] = __builtin_amdgcn_mfma_f32_16x16x32_bf16(vf[dt & 1][q], pb[0][q], oacc[dt][0], 0, 0, 0);
                    oacc[dt][1] = __builtin_amdgcn_mfma_f32_16x16x32_bf16(vf[dt & 1][q], pb[1][q], oacc[dt][1], 0, 0, 0); }
                __builtin_amdgcn_sched_barrier(0);
            }
        }
        if (i + 1 < nt) { ATT_STOREK((i + 1) & 1); ATT_STOREV((i + 1) & 1); }
        __syncthreads();
    }
#undef ATT_LOADK
#undef ATT_STOREK
#undef ATT_LOADV
#undef ATT_STOREV
#pragma unroll
    for (int qt = 0; qt < 2; ++qt) {
        float l = lrun[qt]; l += __shfl_xor(l, 16); l += __shfl_xor(l, 32);
        const float inv = 1.f / l;
#pragma unroll
        for (int dt = 0; dt < 8; ++dt) { const f32x4 o = oacc[dt][qt] * inv; u32x2 w; w.x = cvt_pk_bf16(o.x, o.y); w.y = cvt_pk_bf16(o.z, o.w);
            *(u32x2*)(out + (size_t)(wid * 32 + qt * 16 + fr) * out_stride + dt * 16 + 4 * g) = w; }
    }
}
constexpr float LOG2E = 1.4426950408889634f;
__device__ __forceinline__ void mla_unit(PP P, LAS unsigned char* lds, bool ctxq, int b, int h, int qb) {
    const bf16_t* QM = (const bf16_t*)(lws(P->ws) + OFF_QM); const bf16_t* KN = (const bf16_t*)(lws(P->ws) + OFF_KN); const bf16_t* KR = (const bf16_t*)(lws(P->ws) + OFF_KR);
    const bf16_t* VTM = (const bf16_t*)(lws(P->ws) + OFF_VTM); bf16_t* MIX = (bf16_t*)(lws(P->ws) + OFF_MIX);
    const int row0 = ctxq ? ML + b * CTXL : b * SEQ + 256 * qb;
    attn_block<2>(lds, QM + (size_t)row0 * UQW + h * 128, UQW, QM + (size_t)row0 * UQW + 768 + h * 64, UQW,
                  KN + (size_t)(b * 6 + h) * NKEY * 128, KR + (size_t)b * NKEY * 64, VTM + (size_t)(b * 6 + h) * 128 * NKEY,
                  ctxq ? 4 : 36, 0, 0, 0, 0.07216878364870322f * LOG2E, -1e30f, 0.f, MIX + (size_t)row0 * DM + 1280 + h * 128, DM);
}
__device__ __forceinline__ void swa_unit(PP P, LAS unsigned char* lds, int layer, bool ctxq, int b, int h, int qb) {
    const bf16_t* QS = (const bf16_t*)(lws(P->ws) + OFF_QS); const bf16_t* KS = (const bf16_t*)(lws(P->ws) + OFF_KS); const bf16_t* VTS = (const bf16_t*)(lws(P->ws) + OFF_VTS);
    bf16_t* MIX = (bf16_t*)(lws(P->ws) + OFF_MIX);
    const int q0 = 256 * qb, row0 = ctxq ? ML + b * CTXL : b * SEQ + q0;
    int k1 = 0, n1 = 0;
    if (!ctxq) { const int lo = q0 - 128 < 0 ? 0 : q0 - 128, hi = q0 + 384 > SEQ ? SEQ : q0 + 384; k1 = CTXL + lo; n1 = (hi - lo) >> 6; }
    const int kvh = h / 3;
    const float sink = P->in[22][layer * 6 + h] * LOG2E;
    attn_block<0>(lds, QS + (size_t)row0 * 768 + h * 128, 768, nullptr, 0,
                  KS + (size_t)(b * 2 + kvh) * NKEY * 128, nullptr, VTS + (size_t)(b * 2 + kvh) * 128 * NKEY,
                  4, k1, n1, q0, 0.08838834764831845f * LOG2E, sink, 1.f, MIX + (size_t)row0 * DM + 512 + h * 128, DM);
}
__device__ __forceinline__ void phase_att(PP P, LAS unsigned char* lds, int layer, bool need_ctx, int bid) {
    const int x = bid & 7;
    if (bid < 192) { const int j = bid >> 3, bh = x * 3 + (j >> 3); mla_unit(P, lds, false, bh / 6, bh % 6, j & 7); }
    else {
        const int y = (bid - 192) >> 3;
#pragma unroll 1
        for (int r = 0; r < 3; ++r) { const int bh = r * 8 + x; swa_unit(P, lds, layer, false, bh / 6, bh % 6, y); }
        const int j = bid - 192;
        if (need_ctx) { if (j < 24) mla_unit(P, lds, true, j / 6, j % 6, 0); else if (j < 48) swa_unit(P, lds, layer, true, (j - 24) / 6, (j - 24) % 6, 0); }
    }
}

__global__ void __launch_bounds__(512, 2) mega_fwd(Params Pval) {
#define P (kparams())
    extern __shared__ __attribute__((aligned(16))) unsigned char lds_raw[];
    LAS unsigned char* lds = (LAS unsigned char*)lds_raw;
    cg::grid_group grid = cg::this_grid();
    const int G = gridDim.x;
#define bid (obid())
    volatile LAS unsigned* xst = (volatile LAS unsigned*)(lds + 131072);
    if (threadIdx.x == 0) { xst[0] = 0u; xst[1] = 0u; }
    __syncthreads();
    (void)xcd_barrier_post((unsigned*)(lws(P->ws) + OFF_BAR), xst);
#define GRID_BARRIER() do { XcdBarrier xb_; xb_.bar = (unsigned*)(lws(P->ws) + OFF_BAR); xb_.x = xb_xcc_id(); xb_.st = (volatile LAS unsigned*)(lds + 131072); xcd_barrier(xb_); } while (0)

#ifndef SKIP_PREP
    phase_prep(P, lds, G);
#ifdef DUP_PREP
    __syncthreads();
    phase_prep(P, lds, G);
#endif
#endif
    if (P->ws == nullptr) grid.sync();
    GRID_BARRIER();
#ifndef SKIP_ROWS
    phase_rows(P, 0, 0, G);
#endif
    GRID_BARRIER();
#pragma unroll 1
    for (int layer = 0; layer < 2; ++layer) {
        const bool need_ctx = layer == 0;
        const int Mo = need_ctx ? MT : ML;
        { Gemm g{(const bf16_t*)(lws(P->ws) + OFF_H), (const bf16_t*)(lws(P->ws) + (size_t)layer * WL_STRIDE + OFF_WIN), MT, INWP, DM, DM, DM}; StaticOrder S; S.init(MT, INWP, G, bid);
          EpiInProj E{lws(P->ws)};
#ifndef SKIP_G1

#ifdef DUP_G1
_Pragma("unroll 1")
          for (int rep = 0; rep < 2; ++rep)
#endif
          pg8::gemm_phase(lds, g, S, E);

#endif
        }
        GRID_BARRIER();
#ifndef SKIP_S5
        phase_s5(P, lds, layer, G);
#ifdef DUP_S5
        phase_s5(P, lds, layer, G);
#endif
#endif
        GRID_BARRIER();
#ifndef SKIP_YC
        phase_ycombine(P, layer, G);
#endif
        { Gemm g{(const bf16_t*)(lws(P->ws) + OFF_CQ), (const bf16_t*)(lws(P->ws) + (size_t)layer * WL_STRIDE + OFF_WUQ), Mo, UQWP, 768, 768, 768}; StaticOrder S; S.init(Mo, UQWP, G, bid);
          EpiUQ E{(bf16_t*)(lws(P->ws) + OFF_QM), (const float*)(lws(P->ws) + OFF_RSQ), (const float*)(lws(P->ws) + OFF_TMLA)};

#ifdef DUP_G2
_Pragma("unroll 1")
          for (int rep = 0; rep < 2; ++rep)
#endif
          pg8::gemm_phase(lds, g, S, E);
 }
        { Gemm g{(const bf16_t*)(lws(P->ws) + OFF_CKV), (const bf16_t*)(lws(P->ws) + (size_t)layer * WL_STRIDE + OFF_WUKV), MT, UKVW, 512, 512, 512}; StaticOrder S; S.init(MT, UKVW, G, (bid + 76) % G);
          EpiUKV E{(bf16_t*)(lws(P->ws) + OFF_KN), (bf16_t*)(lws(P->ws) + OFF_VTM), (const float*)(lws(P->ws) + OFF_RSKV)};

#ifdef DUP_G2
_Pragma("unroll 1")
          for (int rep = 0; rep < 2; ++rep)
#endif
          pg8::gemm_phase(lds, g, S, E);
 }
        GRID_BARRIER();
        {
#ifndef SKIP_ATT
            phase_att(P, lds, layer, need_ctx, bid);
#ifdef DUP_ATT
            phase_att(P, lds, layer, need_ctx, bid);
#endif
#endif
            __syncthreads();
            Gemm g{(const bf16_t*)(lws(P->ws) + OFF_G), (const bf16_t*)(lws(P->ws) + (size_t)layer * WL_STRIDE + OFF_WGLU), Mo, 512, 512, 512, 512}; StaticOrder S; S.init(Mo, 512, 64, bid >= 192 ? ((bid - 192 + 16) & 63) : -1);
            EpiGLU E{(const bf16_t*)(lws(P->ws) + OFF_G), P->in[21] + layer * 512, (bf16_t*)(lws(P->ws) + OFF_MIX)};

#ifdef DUP_GLU
_Pragma("unroll 1")
          for (int rep = 0; rep < 2; ++rep)
#endif
          pg8::gemm_phase(lds, g, S, E);

        }
        GRID_BARRIER();
        { Gemm g{(const bf16_t*)(lws(P->ws) + OFF_MIX), (const bf16_t*)(lws(P->ws) + (size_t)layer * WL_STRIDE + OFF_WOUT), ML, DM, DM, DM, DM}; StaticOrder S; S.init(ML, DM, G, bid);
          EpiBf16Out E{(bf16_t*)(lws(P->ws) + OFF_O), DM, 0};
#ifdef DUP_G3
_Pragma("unroll 1")
          for (int rep = 0; rep < 2; ++rep)
#endif
          pg8::gemm_phase(lds, g, S, E);
        }
        if (need_ctx) { Gemm g{(const bf16_t*)(lws(P->ws) + OFF_MIX) + (size_t)ML * DM, (const bf16_t*)(lws(P->ws) + (size_t)layer * WL_STRIDE + OFF_WOUT), MC, DM, 256, DM, DM}; StaticOrder S; S.init(MC, DM, G, bid, 8);
          EpiBf16Out E{(bf16_t*)(lws(P->ws) + OFF_OPART), DM, (size_t)MC * DM};
#ifdef DUP_G3
_Pragma("unroll 1")
          for (int rep = 0; rep < 2; ++rep)
#endif
          pg8::gemm_phase(lds, g, S, E);
        }
        GRID_BARRIER();
#ifndef SKIP_ROWS
        phase_rows(P, 1, layer, G);
#ifdef DUP_ROWS1
        if (layer == 0) phase_rows(P, 1, layer, G);
#endif
#endif
        GRID_BARRIER();
        { Gemm g{(const bf16_t*)(lws(P->ws) + OFF_H), (const bf16_t*)(lws(P->ws) + (size_t)layer * WL_STRIDE + OFF_W1), Mo, DFF, DM, DM, DM}; StaticOrder S; S.init(Mo, DFF, G, bid);
          EpiSqRelu E{(bf16_t*)(lws(P->ws) + OFF_A1), DFF};

#ifdef DUP_FFN1
_Pragma("unroll 1")
          for (int rep = 0; rep < 2; ++rep)
#endif
          pg8::gemm_phase(lds, g, S, E);
 }
        GRID_BARRIER();
        { Gemm g{(const bf16_t*)(lws(P->ws) + OFF_A1), (const bf16_t*)(lws(P->ws) + (size_t)layer * WL_STRIDE + OFF_W2), ML, DM, DFF, DFF, DFF}; StaticOrder S; S.init(ML, DM, G, bid);
          EpiBf16Out E{(bf16_t*)(lws(P->ws) + OFF_O), DM, 0};
#ifndef SKIP_GEMM6
          pg8::gemm_phase(lds, g, S, E);
#ifdef DUP_FFN2
          pg8::gemm_phase(lds, g, S, E);
#endif
#endif
        }
        if (need_ctx) { Gemm g{(const bf16_t*)(lws(P->ws) + OFF_A1) + (size_t)ML * DFF, (const bf16_t*)(lws(P->ws) + (size_t)layer * WL_STRIDE + OFF_W2), MC, DM, 1024, DFF, DFF}; StaticOrder S; S.init(MC, DM, G, bid, 8);
          EpiBf16Out E{(bf16_t*)(lws(P->ws) + OFF_OPART), DM, (size_t)MC * DM};
#ifndef SKIP_GEMM6
          pg8::gemm_phase(lds, g, S, E);
#ifdef DUP_FFN2
          pg8::gemm_phase(lds, g, S, E);
#endif
#endif
        }
        GRID_BARRIER();
#ifndef SKIP_ROWS
        phase_rows(P, 2, layer, G);
#endif
#ifdef DUP_SYNC
        for (int rep = 0; rep < 5; ++rep) GRID_BARRIER();
#endif
        if (layer == 0) GRID_BARRIER();
    }
#undef P
#undef bid
}

extern "C" void kernel_launch(void* const* d_in, const int* in_sizes, int n_in, void* d_out, int out_size, void* d_ws, size_t ws_size, hipStream_t stream) {
    static int grid = 0;
    if (grid == 0) {
        if (n_in != 29 || out_size != ML * DM || ws_size < WS_END) { fprintf(stderr, "kernel_launch: unexpected shapes (n_in %d out %d ws %zu need %zu)\n", n_in, out_size, ws_size, (size_t)WS_END); grid = -1; return; }
        int dev = 0, cus = 0, per_cu = 0;
        hipGetDevice(&dev);
        hipDeviceGetAttribute(&cus, hipDeviceAttributeMultiprocessorCount, dev);
        if (hipFuncSetAttribute((const void*)mega_fwd, hipFuncAttributeMaxDynamicSharedMemorySize, LDS_BYTES) != hipSuccess) { fprintf(stderr, "kernel_launch: hipFuncSetAttribute failed\n"); grid = -1; return; }
        hipOccupancyMaxActiveBlocksPerMultiprocessor(&per_cu, (const void*)mega_fwd, 512, LDS_BYTES);
        if (per_cu < 1 || cus < 256) { fprintf(stderr, "kernel_launch: occupancy %d cus %d\n", per_cu, cus); grid = -1; return; }
        grid = 256;
    }
    if (grid < 0) return;
    if (hipMemsetAsync((char*)d_ws + OFF_BAR, 0, 16384, stream) != hipSuccess) { fprintf(stderr, "kernel_launch: memset failed\n"); return; }
    Params p{};
    for (int i = 0; i < 29; ++i) p.in[i] = (const float*)d_in[i];
    p.out = (float*)d_out; p.ws = (unsigned char*)d_ws;
    void* args[] = {&p};
    hipError_t e = hipLaunchCooperativeKernel((const void*)mega_fwd, dim3(grid), dim3(512), args, LDS_BYTES, stream);
    if (e != hipSuccess) fprintf(stderr, "cooperative launch failed: %s\n", hipGetErrorString(e));
}
```

```cpp
#include <hip/hip_runtime.h>
#include <hip/hip_cooperative_groups.h>
#include <cstdio>
#include <cstdint>
namespace cg = cooperative_groups;

#define LAS __attribute__((address_space(3)))
typedef unsigned short bf16_t;
typedef short bf16x8 __attribute__((ext_vector_type(8)));
typedef float f32x4 __attribute__((ext_vector_type(4)));
typedef float f32x2 __attribute__((ext_vector_type(2)));
typedef unsigned u32x4 __attribute__((ext_vector_type(4)));
typedef unsigned u32x2 __attribute__((ext_vector_type(2)));

constexpr int DM = 2048, NBATCH = 4, SEQ = 2048, CTXL = 256, NKEY = SEQ + CTXL;
constexpr int ML = NBATCH * SEQ, MC = NBATCH * CTXL, MT = ML + MC;
constexpr int INW = 3136, INWP = 3328, DFF = 8192, UQW = 1152, UQWP = 1280, UKVW = 1536;
constexpr float EPSN = 1e-6f;
constexpr int LDS_BYTES = 131072 + 16;
constexpr int NWAVES = 8;

constexpr size_t SZ_WIN = (size_t)INWP * DM * 2, SZ_WOUT = (size_t)DM * DM * 2, SZ_WUQ = (size_t)UQWP * 768 * 2, SZ_WUKV = (size_t)UKVW * 512 * 2,
                 SZ_WGLU = (size_t)512 * 512 * 2, SZ_W1 = (size_t)DFF * DM * 2, SZ_W2 = (size_t)DM * DFF * 2;
constexpr size_t OFF_WIN = 0, OFF_WOUT = OFF_WIN + SZ_WIN, OFF_WUQ = OFF_WOUT + SZ_WOUT, OFF_WUKV = OFF_WUQ + SZ_WUQ, OFF_WGLU = OFF_WUKV + SZ_WUKV,
                 OFF_W1 = OFF_WGLU + SZ_WGLU, OFF_W2 = OFF_W1 + SZ_W1, WL_STRIDE = OFF_W2 + SZ_W2;
constexpr size_t OFF_MODS = 2 * WL_STRIDE;
constexpr size_t OFF_TSWA = OFF_MODS + (size_t)2 * 5 * 12288 * 4;
constexpr size_t OFF_TMLA = OFF_TSWA + (size_t)2048 * 64 * 8;
constexpr size_t OFF_XS = OFF_TMLA + (size_t)2048 * 32 * 8;
constexpr size_t OFF_H = OFF_XS + (size_t)MT * DM * 4;
constexpr size_t OFF_O = OFF_H + (size_t)MT * DM * 2;
constexpr size_t OFF_R = OFF_O + (size_t)MT * DM * 4;
constexpr size_t OFF_A1 = OFF_R;
constexpr size_t OFF_U = OFF_R;
constexpr size_t OFF_QS = OFF_U + (size_t)MT * 512 * 2;
constexpr size_t OFF_KS = OFF_QS + (size_t)MT * 768 * 2;
constexpr size_t OFF_VTS = OFF_KS + (size_t)NBATCH * 2 * NKEY * 128 * 2;
constexpr size_t OFF_CQ = OFF_VTS + (size_t)NBATCH * 2 * NKEY * 128 * 2;
constexpr size_t OFF_CKV = OFF_CQ + (size_t)MT * 768 * 2;
constexpr size_t OFF_KR = OFF_CKV + (size_t)MT * 512 * 2;
constexpr size_t OFF_RSQ = OFF_KR + (size_t)NBATCH * NKEY * 64 * 2;
constexpr size_t OFF_RSKV = OFF_RSQ + (size_t)MT * 4;
constexpr size_t OFF_YDIR = OFF_RSKV + (size_t)MT * 4;
constexpr size_t OFF_G = OFF_YDIR + (size_t)2 * MT * 512 * 4;
constexpr size_t OFF_QM = OFF_G + (size_t)MT * 512 * 2;
constexpr size_t OFF_KN = OFF_QM + (size_t)MT * UQW * 2;
constexpr size_t OFF_VTM = OFF_KN + (size_t)NBATCH * 6 * NKEY * 128 * 2;
constexpr size_t OFF_MIX = OFF_VTM + (size_t)NBATCH * 6 * NKEY * 128 * 2;
constexpr size_t END_MIXER = OFF_MIX + (size_t)MT * DM * 2;
constexpr size_t END_A1 = OFF_A1 + (size_t)MT * DFF * 2;
constexpr size_t OFF_BAR = ((END_MIXER > END_A1 ? END_MIXER : END_A1) + 255) & ~(size_t)255;
constexpr size_t OFF_OPART = OFF_BAR + 16384;
constexpr size_t WS_END = OFF_OPART + (size_t)8 * MC * DM * 4;

struct Params { const float* in[29]; float* out; unsigned char* ws; };
typedef const Params __attribute__((address_space(4)))* PP;
__device__ __forceinline__ PP kparams() { PP p = (PP)__builtin_amdgcn_kernarg_segment_ptr(); asm volatile("" : "+s"(p)); return p; }

typedef __bf16 bf16v2 __attribute__((ext_vector_type(2)));
__device__ __forceinline__ unsigned cvt_pk_bf16(float lo, float hi) { const f32x2 v = {lo, hi}; const bf16v2 b = __builtin_convertvector(v, bf16v2); return __builtin_bit_cast(unsigned, b); }
__device__ __forceinline__ float bf_lo(unsigned w) { return __uint_as_float(w << 16); }
__device__ __forceinline__ float bf_hi(unsigned w) { return __uint_as_float(w & 0xffff0000u); }
__device__ __forceinline__ float wave_sum(float v) {
#pragma unroll
    for (int o = 1; o < 64; o <<= 1) v += __shfl_xor(v, o);
    return v;
}
#define LDS_WAIT() asm volatile("s_waitcnt lgkmcnt(0)" ::: "memory")
__device__ __forceinline__ unsigned char* lws(unsigned char* p) { asm volatile("" : "+s"(p)); return p; }
__device__ __forceinline__ int obid() { int b = blockIdx.x; asm volatile("" : "+s"(b)); return b; }
__device__ __forceinline__ int otid() { int t = threadIdx.x; asm volatile("" : "+v"(t)); return t; }


#define XB_TMO      128
#define XB_XCNT(j)  (256  + 64 * (j))
#define XB_XSUB(j)  (1280 + 64 * (j))
#define XB_XGEN(j)  (2304 + 64 * (j))
#define XB_TOP      3328
#define XB_TOPGEN   3392
#define XCD_BAR_WORDS 3456
#define XB_SPIN_CAP (1u << 18)
__device__ __forceinline__ unsigned xb_ld(unsigned* p)              { return __hip_atomic_load(p, __ATOMIC_RELAXED, __HIP_MEMORY_SCOPE_AGENT); }
__device__ __forceinline__ unsigned xb_add(unsigned* p, unsigned v) { return __hip_atomic_fetch_add(p, v, __ATOMIC_RELAXED, __HIP_MEMORY_SCOPE_AGENT); }
__device__ __forceinline__ unsigned xb_xcc_id() { return (unsigned)__builtin_amdgcn_s_getreg((3 << 11) | 20) & 0xFu; }
#define XB_SPIN(cond, bar) do { unsigned _sp = 0; while (cond) { __builtin_amdgcn_s_sleep(1); \
    if ((++_sp & 255u) == 0u) { if (xb_ld(&(bar)[XB_TMO])) break; if (_sp > XB_SPIN_CAP) { atomicAdd(&(bar)[XB_TMO], 1u); break; } } } } while (0)
struct XcdBarrier { unsigned* bar; unsigned x; volatile LAS unsigned* st; };
__device__ __forceinline__ XcdBarrier xcd_barrier_post(unsigned* bar, volatile LAS unsigned* st) {
    XcdBarrier b; b.bar = bar; b.x = xb_xcc_id(); b.st = st;
    if (threadIdx.x == 0) (void)xb_add(&bar[XB_XCNT(b.x)], 1u);
    return b;
}
__device__ __forceinline__ void xcd_barrier_complete(unsigned* bar, unsigned x, unsigned& nloc, unsigned& nx) {
    const unsigned G = gridDim.x * gridDim.y * gridDim.z;
    unsigned sum, cnt, mine, sp = 0u;
    for (;;) {
        sum = 0u; cnt = 0u; mine = 0u;
#pragma unroll
        for (unsigned j = 0; j < 16; ++j) { const unsigned c = xb_ld(&bar[XB_XCNT(j)]); sum += c; cnt += (c > 0u) ? 1u : 0u; mine = (j == x) ? c : mine; }
        if (sum == G) break;
        __builtin_amdgcn_s_sleep(1);
        if ((++sp & 255u) == 0u) { if (xb_ld(&bar[XB_TMO])) break; if (sp > XB_SPIN_CAP) { atomicAdd(&bar[XB_TMO], 1u); break; } }
    }
    nloc = mine > 0u ? mine : 1u; nx = cnt > 0u ? cnt : 1u;
}
__device__ __forceinline__ void xcd_barrier(const XcdBarrier& b) {
    asm volatile("s_waitcnt vmcnt(0)" ::: "memory");
    __syncthreads();
    if (threadIdx.x == 0) {
        unsigned* bar = b.bar;
        __builtin_amdgcn_s_waitcnt(0);
        unsigned nloc = b.st[0], nx = b.st[1];
        if (nloc == 0u) { xcd_barrier_complete(bar, b.x, nloc, nx); b.st[0] = nloc; b.st[1] = nx; }
        const unsigned old = xb_add(&bar[XB_XSUB(b.x)], 1u);
        const unsigned gen = old / nloc;
        if (old + 1u == (gen + 1u) * nloc) {
            __builtin_amdgcn_fence(__ATOMIC_RELEASE, "agent");
            asm volatile("s_waitcnt vmcnt(0)" ::: "memory");
            const unsigned og = xb_add(&bar[XB_TOP], 1u);
            const unsigned tg = og / nx;
            if (og + 1u == (tg + 1u) * nx) xb_add(&bar[XB_TOPGEN], 1u);
            else XB_SPIN(xb_ld(&bar[XB_TOPGEN]) == tg, bar);
            __builtin_amdgcn_fence(__ATOMIC_ACQUIRE, "agent");
            xb_add(&bar[XB_XGEN(b.x)], 1u);
            asm volatile("s_waitcnt vmcnt(0)" ::: "memory");
        } else {
            XB_SPIN(xb_ld(&bar[XB_XGEN(b.x)]) == gen, bar);
            __builtin_amdgcn_fence(__ATOMIC_ACQUIRE, "agent");
            asm volatile("s_waitcnt vmcnt(0)" ::: "memory");
        }
    }
    __syncthreads();
}

namespace pg8 {
constexpr int BM = 256, BK = 64, HALF = 128, HTB = HALF * BK * 2, STAGE_BYTES = 8 * HTB, NXCD = 8, WGM = 8;
__host__ __device__ __forceinline__ int lds_byte(int r, int c) { const int st = (r >> 4) * 2 + (c >> 5), rr = r & 15, cc = c & 31, ob = rr * 64 + cc * 2; return st * 1024 + (ob ^ (((ob >> 9) & 1) << 5)); }
__host__ __device__ __forceinline__ void stage_rc(int b, int& R, int& C) { const int st = b / 1024, sb = b % 1024, swz = sb ^ (((sb >> 9) & 1) << 5); R = (st >> 1) * 16 + swz / 64; C = (st & 1) * 32 + (swz % 64) / 2; }
__host__ __device__ __forceinline__ int perm32(int rho) { const int n = rho >> 4, i = rho & 15; return 8 * (i >> 2) + 4 * n + (i & 3); }
struct Unit { int pm, pn, kc; };
struct Gemm { const bf16_t* A; const bf16_t* Bt; int M, N, K, lda, ldb; };
struct StaticOrder {
    int nM, nN, nwg, G, c, tiles;
    __host__ __device__ void init(int M, int N, int G_, int c_, int ksplit = 1) { nM = M / BM; nN = N / BM; tiles = nM * nN; nwg = tiles * ksplit; G = G_; c = c_; }
    __host__ __device__ bool next(int i, Unit& u) const {
        if (c < 0) return false;
        const long L = (long)i * G + c; if (L >= nwg) return false;
        u.kc = (int)L / tiles;
        int wgid = (int)L % tiles; { const int q = tiles / NXCD, r = tiles % NXCD, xcd = wgid % NXCD, off = wgid / NXCD; wgid = (xcd < r ? xcd * (q + 1) : r * (q + 1) + (xcd - r) * q) + off; }
        const int nig = WGM * nN, gid = wgid / nig, fm = gid * WGM, gsz = (nM - fm) < WGM ? (nM - fm) : WGM;
        u.pm = fm + ((wgid % nig) % gsz); u.pn = (wgid % nig) / gsz; return true;
    }
};
template <class Epi>
__device__ __forceinline__ void gemm_phase(LAS unsigned char* lds, const Gemm g, const StaticOrder& S, const Epi& E) {
    const int tid = otid(), wid = __builtin_amdgcn_readfirstlane(tid >> 6), lane = tid & 63, wr = wid >> 2, wc = wid & 3, fr = lane & 15, fq = lane >> 4;
    const int K = g.K, nt = K / BK;
    unsigned voffA, voffB;
    { int R, C; stage_rc(tid * 16, R, C); const int Rb = Epi::PERM ? ((R & ~31) + perm32(R & 31)) : R;
      voffA = (unsigned)(R * g.lda + C) * 2u; voffB = (unsigned)(Rb * g.ldb + C) * 2u; }
    const size_t r64voffA = (size_t)64 * g.lda * 2, r64voffB = (size_t)64 * g.ldb * 2;
    const size_t kstep = (size_t)(BK * 2);
    const size_t hstepA = (size_t)HALF * g.lda * 2, hstepB = (size_t)HALF * g.ldb * 2;
    const size_t tstepA = 2 * hstepA, tstepB = 2 * hstepB, cstep = (size_t)K * 2;
    const unsigned ldsw = (unsigned)wid * 1024u;
    const int aoff = lds_byte(wr * 64 + fr, fq * 8), boff = lds_byte(wc * 32 + fr, fq * 8);
#define PG8_SA(b, h) (((b) * 2 + (h)) * HTB)
#define PG8_SB(b, h) ((4 + (b) * 2 + (h)) * HTB)
#define PG8_STAGE(bufoff, gbase, voff) do { _Pragma("unroll") for (int _i = 0; _i < 2; ++_i) \
        __builtin_amdgcn_global_load_lds((const unsigned*)((const char*)(gbase) + _i * r64##voff + (voff)), (LAS unsigned*)(lds + (bufoff) + ldsw + _i * 8192), 16, 0, 0); } while (0)
#define PG8_LDA(dst, b, h) do { _Pragma("unroll") for (int m = 0; m < 4; ++m) _Pragma("unroll") for (int k = 0; k < 2; ++k) dst[m][k] = *(const LAS bf16x8*)(lds + PG8_SA(b, h) + aoff + m * 2048 + k * 1024); } while (0)
#define PG8_LDB(dst, b, h) do { _Pragma("unroll") for (int n = 0; n < 2; ++n) _Pragma("unroll") for (int k = 0; k < 2; ++k) dst[n][k] = *(const LAS bf16x8*)(lds + PG8_SB(b, h) + boff + n * 2048 + k * 1024); } while (0)
#define PG8_MMA(ai, bj, At, Bt) do { __builtin_amdgcn_s_setprio(1); _Pragma("unroll") for (int m = 0; m < 4; ++m) _Pragma("unroll") for (int n = 0; n < 2; ++n) _Pragma("unroll") for (int k = 0; k < 2; ++k) \
        acc[ai][bj][m][n] = __builtin_amdgcn_mfma_f32_16x16x32_bf16(Bt[n][k], At[m][k], acc[ai][bj][m][n], 0, 0, 0); __builtin_amdgcn_s_setprio(0); } while (0)
#define PG8_WAIT_V(n) asm volatile("s_waitcnt vmcnt(" #n ")" ::: "memory")
#define PG8_WAIT_L(n) asm volatile("s_waitcnt lgkmcnt(" #n ")" ::: "memory")
#define PG8_BAR __builtin_amdgcn_s_barrier()
#define PG8_SCHED __builtin_amdgcn_sched_barrier(0)
    Unit cur, nxt; int ui = 0;
    if (!S.next(0, cur)) return;
    f32x4 acc[2][2][4][2];
#pragma unroll
    for (int a = 0; a < 2; ++a)
#pragma unroll
        for (int b = 0; b < 2; ++b)
#pragma unroll
            for (int m = 0; m < 4; ++m)
#pragma unroll
                for (int n = 0; n < 2; ++n) acc[a][b][m][n] = (f32x4){0.f, 0.f, 0.f, 0.f};
    bf16x8 At[4][2], B0[2][2], B1[2][2];
    const char* cA = (const char*)g.A + (size_t)cur.pm * tstepA + (size_t)cur.kc * cstep; const char* cB = (const char*)g.Bt + (size_t)cur.pn * tstepB + (size_t)cur.kc * cstep;
    PG8_STAGE(PG8_SB(0, 0), cB, voffB); PG8_STAGE(PG8_SB(0, 1), cB + hstepB, voffB); PG8_STAGE(PG8_SA(0, 0), cA, voffA); PG8_STAGE(PG8_SA(0, 1), cA + hstepA, voffA);
    if (wr == 1) PG8_BAR;
    PG8_WAIT_V(2); PG8_BAR;
    PG8_STAGE(PG8_SB(1, 0), cB + kstep, voffB); PG8_STAGE(PG8_SA(1, 0), cA + kstep, voffA); PG8_STAGE(PG8_SB(1, 1), cB + hstepB + kstep, voffB);
    PG8_WAIT_V(6); PG8_BAR;
    for (;;) {
        const bool has_next = S.next(ui + 1, nxt);
        const char* nA = has_next ? (const char*)g.A + (size_t)nxt.pm * tstepA + (size_t)nxt.kc * cstep : cA; const char* nB = has_next ? (const char*)g.Bt + (size_t)nxt.pn * tstepB + (size_t)nxt.kc * cstep : cB;
        for (int t = 0; t < nt; t += 2) {
            const bool last = (t == nt - 2);
            const char* a1 = cA + (size_t)(t + 1) * kstep;
            const char* a2 = last ? nA : cA + (size_t)(t + 2) * kstep; const char* b2 = last ? nB : cB + (size_t)(t + 2) * kstep;
            const char* a3 = a2 + kstep; const char* b3 = b2 + kstep;
            PG8_LDB(B0, 0, 0); PG8_LDB(B1, 0, 1); PG8_SCHED; PG8_LDA(At, 0, 0); PG8_STAGE(PG8_SA(1, 1), a1 + hstepA, voffA);
            PG8_WAIT_V(8); PG8_WAIT_L(0); PG8_BAR; PG8_MMA(0, 0, At, B0); PG8_MMA(0, 1, At, B1); PG8_BAR; PG8_SCHED;
            PG8_LDA(At, 0, 1); PG8_STAGE(PG8_SB(0, 0), b2, voffB); PG8_STAGE(PG8_SB(0, 1), b2 + hstepB, voffB); PG8_STAGE(PG8_SA(0, 0), a2, voffA);
            PG8_WAIT_V(8); PG8_WAIT_L(0); PG8_BAR; PG8_MMA(1, 0, At, B0); PG8_MMA(1, 1, At, B1); PG8_BAR; PG8_SCHED;
            PG8_LDB(B0, 1, 0); PG8_LDB(B1, 1, 1); PG8_SCHED; PG8_LDA(At, 1, 0); PG8_STAGE(PG8_SA(0, 1), a2 + hstepA, voffA);
            PG8_WAIT_V(8); PG8_WAIT_L(0); PG8_BAR; PG8_MMA(0, 0, At, B0); PG8_MMA(0, 1, At, B1); PG8_BAR; PG8_SCHED;
            PG8_LDA(At, 1, 1); PG8_STAGE(PG8_SB(1, 0), b3, voffB); PG8_STAGE(PG8_SB(1, 1), b3 + hstepB, voffB); PG8_STAGE(PG8_SA(1, 0), a3, voffA);
            PG8_WAIT_V(8); PG8_WAIT_L(0); PG8_BAR; PG8_MMA(1, 0, At, B0); PG8_MMA(1, 1, At, B1); PG8_BAR; PG8_SCHED;
        }
        if (wr == 0) PG8_BAR;
        E(acc, cur, wr, wc, fr, fq);
        if (!has_next) break;
#pragma unroll
        for (int a = 0; a < 2; ++a)
#pragma unroll
            for (int b = 0; b < 2; ++b)
#pragma unroll
                for (int m = 0; m < 4; ++m)
#pragma unroll
                    for (int n = 0; n < 2; ++n) acc[a][b][m][n] = (f32x4){0.f, 0.f, 0.f, 0.f};
        cur = nxt; cA = nA; cB = nB; ++ui;
        if (wr == 1) PG8_BAR;
    }
    PG8_WAIT_V(0);
    PG8_BAR;
#undef PG8_SA
#undef PG8_SB
#undef PG8_STAGE
#undef PG8_LDA
#undef PG8_LDB
#undef PG8_MMA
#undef PG8_WAIT_V
#undef PG8_WAIT_L
#undef PG8_BAR
#undef PG8_SCHED
}
}
using pg8::Unit; using pg8::Gemm; using pg8::StaticOrder;

__device__ __forceinline__ void rope8(f32x4& v0, f32x4& v1, const float* tab) {
    const f32x4 t0 = *(const f32x4*)tab, t1 = *(const f32x4*)(tab + 4);
    float a, b;
    a = v0.x * t0.x - v0.y * t0.y; b = v0.y * t0.x + v0.x * t0.y; v0.x = a; v0.y = b;
    a = v0.z * t0.z - v0.w * t0.w; b = v0.w * t0.z + v0.z * t0.w; v0.z = a; v0.w = b;
    a = v1.x * t1.x - v1.y * t1.y; b = v1.y * t1.x + v1.x * t1.y; v1.x = a; v1.y = b;
    a = v1.z * t1.z - v1.w * t1.w; b = v1.w * t1.z + v1.z * t1.w; v1.z = a; v1.w = b;
}
__device__ __forceinline__ u32x4 pack8(const f32x4 v0, const f32x4 v1) {
    u32x4 w; w.x = cvt_pk_bf16(v0.x, v0.y); w.y = cvt_pk_bf16(v0.z, v0.w); w.z = cvt_pk_bf16(v1.x, v1.y); w.w = cvt_pk_bf16(v1.z, v1.w); return w;
}
__device__ __forceinline__ void row_decode(int row, bool& lat, int& b, int& t, int& keyidx) {
    lat = row < ML;
    if (lat) { b = row >> 11; t = row & 2047; keyidx = CTXL + t; } else { const int r2 = row - ML; b = r2 >> 8; t = r2 & 255; keyidx = t; }
}
__device__ __forceinline__ void store_vt8(bf16_t* vt, int d0, int keyidx, const u32x4 w) {
    const int kp = (keyidx & ~31) | (((keyidx >> 2) & 3) << 3) | (((keyidx >> 4) & 1) << 2) | (keyidx & 3);
    bf16_t* p = vt + (size_t)d0 * NKEY + kp;
    p[0] = (bf16_t)(w.x & 0xffff); p[NKEY] = (bf16_t)(w.x >> 16); p[2 * NKEY] = (bf16_t)(w.y & 0xffff); p[3 * NKEY] = (bf16_t)(w.y >> 16);
    p[4 * NKEY] = (bf16_t)(w.z & 0xffff); p[5 * NKEY] = (bf16_t)(w.z >> 16); p[6 * NKEY] = (bf16_t)(w.w & 0xffff); p[7 * NKEY] = (bf16_t)(w.w >> 16);
}

struct EpiInProj {
    static constexpr bool PERM = true;
    unsigned char* wsb;
    __device__ __forceinline__ void operator()(const f32x4 (&acc)[2][2][4][2], const Unit& u, int wr, int wc, int fr, int fq) const {
        const int pn = u.pn, cw = wc * 32 + fq * 8;
        bf16_t* const U = (bf16_t*)(wsb + OFF_U); bf16_t* const QS = (bf16_t*)(wsb + OFF_QS); bf16_t* const KS = (bf16_t*)(wsb + OFF_KS); bf16_t* const VTS = (bf16_t*)(wsb + OFF_VTS);
        bf16_t* const CQ = (bf16_t*)(wsb + OFF_CQ); bf16_t* const CKV = (bf16_t*)(wsb + OFF_CKV); bf16_t* const KR = (bf16_t*)(wsb + OFF_KR);
        const float* const tswa = (const float*)(wsb + OFF_TSWA); const float* const tmla = (const float*)(wsb + OFF_TMLA);
#pragma unroll
        for (int ai = 0; ai < 2; ++ai)
#pragma unroll
            for (int m = 0; m < 4; ++m) {
                const int row = u.pm * 256 + ai * 128 + wr * 64 + m * 16 + fr;
                bool lat; int b, t, keyidx; row_decode(row, lat, b, t, keyidx);
#pragma unroll
                for (int bj = 0; bj < 2; ++bj) {
                    f32x4 v0 = acc[ai][bj][m][0], v1 = acc[ai][bj][m][1];
                    const int cl = bj * 128 + cw;
                    if (pn < 2) { const int cu = pn * 256 + cl; *(u32x4*)(U + (((size_t)(b * 32 + (cu >> 4)) * NKEY + keyidx) << 4) + (cu & 15)) = pack8(v0, v1); }
                    else if (pn < 5) { if (lat) rope8(v0, v1, tswa + ((size_t)t * 64 + (cw >> 1)) * 2); *(u32x4*)(QS + (size_t)row * 768 + (pn - 2) * 256 + cl) = pack8(v0, v1); }
                    else if (pn == 5) { if (lat) rope8(v0, v1, tswa + ((size_t)t * 64 + (cw >> 1)) * 2); *(u32x4*)(KS + ((size_t)(b * 2 + bj) * NKEY + keyidx) * 128 + cw) = pack8(v0, v1); }
                    else if (pn == 6) { store_vt8(VTS + (size_t)(b * 2 + bj) * 128 * NKEY, cw, keyidx, pack8(v0, v1)); }
                    else if (pn < 10) { *(u32x4*)(CQ + (size_t)row * 768 + (pn - 7) * 256 + cl) = pack8(v0, v1); }
                    else if (pn < 12) { *(u32x4*)(CKV + (size_t)row * 512 + (pn - 10) * 256 + cl) = pack8(v0, v1); }
                    else { if (bj == 0 && wc < 2) { if (lat) rope8(v0, v1, tmla + ((size_t)t * 32 + (cw >> 1)) * 2); *(u32x4*)(KR + ((size_t)b * NKEY + keyidx) * 64 + cw) = pack8(v0, v1); } }
                }
            }
    }
};
struct EpiUQ {
    static constexpr bool PERM = true;
    bf16_t* QM; const float *rs, *tmla;
    __device__ __forceinline__ void operator()(const f32x4 (&acc)[2][2][4][2], const Unit& u, int wr, int wc, int fr, int fq) const {
#pragma unroll
        for (int ai = 0; ai < 2; ++ai)
#pragma unroll
            for (int m = 0; m < 4; ++m) {
                const int row = u.pm * 256 + ai * 128 + wr * 64 + m * 16 + fr;
                const float r = rs[row]; const bool lat = row < ML; const int t = row & 2047;
#pragma unroll
                for (int bj = 0; bj < 2; ++bj) {
                    const int col = u.pn * 256 + bj * 128 + wc * 32 + fq * 8;
                    if (col < UQW) {
                        f32x4 v0 = acc[ai][bj][m][0] * r, v1 = acc[ai][bj][m][1] * r;
                        if (col >= 768 && lat) rope8(v0, v1, tmla + ((size_t)t * 32 + (((col - 768) & 63) >> 1)) * 2);
                        *(u32x4*)(QM + (size_t)row * UQW + col) = pack8(v0, v1);
                    }
                }
            }
    }
};
struct EpiUKV {
    static constexpr bool PERM = true;
    bf16_t *KN, *VTM; const float* rs;
    __device__ __forceinline__ void operator()(const f32x4 (&acc)[2][2][4][2], const Unit& u, int wr, int wc, int fr, int fq) const {
        const int h = u.pn, cw = wc * 32 + fq * 8;
#pragma unroll
        for (int ai = 0; ai < 2; ++ai)
#pragma unroll
            for (int m = 0; m < 4; ++m) {
                const int row = u.pm * 256 + ai * 128 + wr * 64 + m * 16 + fr;
                bool lat; int b, t, keyidx; row_decode(row, lat, b, t, keyidx);
                const float r = rs[row];
                *(u32x4*)(KN + ((size_t)(b * 6 + h) * NKEY + keyidx) * 128 + cw) = pack8(acc[ai][0][m][0] * r, acc[ai][0][m][1] * r);
                store_vt8(VTM + (size_t)(b * 6 + h) * 128 * NKEY, cw, keyidx, pack8(acc[ai][1][m][0] * r, acc[ai][1][m][1] * r));
            }
    }
};
struct EpiGLU {
    static constexpr bool PERM = true;
    const bf16_t* G; const float* bias; bf16_t* MIX;
    __device__ __forceinline__ void operator()(const f32x4 (&acc)[2][2][4][2], const Unit& u, int wr, int wc, int fr, int fq) const {
#pragma unroll
        for (int bj = 0; bj < 2; ++bj) {
            const int col = u.pn * 256 + bj * 128 + wc * 32 + fq * 8;
            const f32x4 b0 = *(const f32x4*)(bias + col), b1 = *(const f32x4*)(bias + col + 4);
#pragma unroll
            for (int ai = 0; ai < 2; ++ai)
#pragma unroll
                for (int m = 0; m < 4; ++m) {
                    const int row = u.pm * 256 + ai * 128 + wr * 64 + m * 16 + fr;
                    const u32x4 gw = *(const u32x4*)(G + (size_t)row * 512 + col);
                    const f32x4 z0 = acc[ai][bj][m][0] + b0, z1 = acc[ai][bj][m][1] + b1;
                    f32x4 o0, o1;
                    o0.x = bf_lo(gw.x) / (1.f + __expf(-z0.x)); o0.y = bf_hi(gw.x) / (1.f + __expf(-z0.y)); o0.z = bf_lo(gw.y) / (1.f + __expf(-z0.z)); o0.w = bf_hi(gw.y) / (1.f + __expf(-z0.w));
                    o1.x = bf_lo(gw.z) / (1.f + __expf(-z1.x)); o1.y = bf_hi(gw.z) / (1.f + __expf(-z1.y)); o1.z = bf_lo(gw.w) / (1.f + __expf(-z1.z)); o1.w = bf_hi(gw.w) / (1.f + __expf(-z1.w));
                    *(u32x4*)(MIX + (size_t)row * DM + col) = pack8(o0, o1);
                }
        }
    }
};
struct EpiBf16Out {
    static constexpr bool PERM = true;
    bf16_t* C; int ldc; size_t kc_stride;
    __device__ __forceinline__ void operator()(const f32x4 (&acc)[2][2][4][2], const Unit& u, int wr, int wc, int fr, int fq) const {
        const int row0 = u.pm * 256 + wr * 64 + fr, col0 = u.pn * 256 + wc * 32 + 8 * fq;
#pragma unroll
        for (int ai = 0; ai < 2; ++ai)
#pragma unroll
            for (int m = 0; m < 4; ++m) { bf16_t* rowp = C + (size_t)u.kc * kc_stride + (size_t)(row0 + ai * 128 + m * 16) * ldc + col0;
#pragma unroll
                for (int bj = 0; bj < 2; ++bj) *(u32x4*)(rowp + bj * 128) = pack8(acc[ai][bj][m][0], acc[ai][bj][m][1]); }
    }
};
struct EpiSqRelu {
    static constexpr bool PERM = true;
    bf16_t* O; int ldc;
    __device__ __forceinline__ void operator()(const f32x4 (&acc)[2][2][4][2], const Unit& u, int wr, int wc, int fr, int fq) const {
        const int row0 = u.pm * 256 + wr * 64 + fr, col0 = u.pn * 256 + wc * 32 + 8 * fq;
#pragma unroll
        for (int ai = 0; ai < 2; ++ai)
#pragma unroll
            for (int m = 0; m < 4; ++m) { bf16_t* rowp = O + (size_t)(row0 + ai * 128 + m * 16) * ldc + col0;
#pragma unroll
                for (int bj = 0; bj < 2; ++bj) {
                    f32x4 v0 = acc[ai][bj][m][0], v1 = acc[ai][bj][m][1];
#pragma unroll
                    for (int j = 0; j < 4; ++j) { const float a = fmaxf(v0[j], 0.f), b = fmaxf(v1[j], 0.f); v0[j] = a * a; v1[j] = b * b; }
                    *(u32x4*)(rowp + bj * 128) = pack8(v0, v1); } }
    }
};

__device__ __forceinline__ int src_col(int mode, int n) {
    if (mode == 1) {
        if (n >= 512 && n < 1536) { const int base = n & ~127, c = n & 127, half = c >> 6, cc = c & 63; return base + half * 64 + (cc >> 1) + 32 * (cc & 1); }
        if (n >= 3072) { const int c = n - 3072, half = c >> 5, cc = c & 31; return 3072 + half * 32 + (cc >> 1) + 16 * (cc & 1); }
        return n;
    }
    if (mode == 2) {
        if (n < 768) return (n >> 7) * 192 + (n & 127);
        const int r = n - 768, h = r >> 6, p = r & 63, half = p >> 5, cc = p & 31; return h * 192 + 128 + half * 32 + (cc >> 1) + 16 * (cc & 1);
    }
    return n;
}
__device__ __forceinline__ void transpose_item(const float* W, int K, int N, int nblk, bf16_t* WT, int mode, const float* kscale, LAS float* scr, int item, int lane) {
    const int kb = item / nblk, nb = item % nblk, k0 = 64 * kb, n0 = 32 * nb;
    const int sc = src_col(mode, n0 + (lane & 31));
    float wv[32];
#pragma unroll
    for (int i = 0; i < 32; ++i) wv[i] = W[(size_t)(k0 + 2 * i + (lane >> 5)) * N + sc];
    if (kscale) {
#pragma unroll
        for (int i = 0; i < 32; ++i) wv[i] *= kscale[k0 + 2 * i + (lane >> 5)];
    }
#pragma unroll
    for (int i = 0; i < 32; ++i) scr[(2 * i + (lane >> 5)) * 33 + (lane & 31)] = wv[i];
    LDS_WAIT();
    const int c = lane & 7;
#pragma unroll
    for (int j = 0; j < 4; ++j) { const int n = (lane >> 3) + 8 * j; const LAS float* s = scr + (8 * c) * 33 + n;
        u32x4 o; o.x = cvt_pk_bf16(s[0 * 33], s[1 * 33]); o.y = cvt_pk_bf16(s[2 * 33], s[3 * 33]); o.z = cvt_pk_bf16(s[4 * 33], s[5 * 33]); o.w = cvt_pk_bf16(s[6 * 33], s[7 * 33]);
        *(u32x4*)(WT + (size_t)(n0 + n) * K + k0 + 8 * c) = o; }
    LDS_WAIT();
}
__device__ __forceinline__ void ada_item(PP P, LAS unsigned char* lds, int item) {
    const int tid = otid(), layer = item / 96, col0 = (item % 96) * 128;
    LAS float* sv = (LAS float*)lds;
    LAS float* part = sv + 5 * 2048;
    for (int i = tid; i < 5 * 2048; i += 512) { const int v = i >> 11, k = i & 2047; const float c = v < 4 ? P->in[1][v * 2048 + k] : P->in[3][k]; sv[i] = c / (1.f + expf(-c)); }
    __syncthreads();
    const int cgp = tid & 31, ks = tid >> 5;
    float acc[5][4];
#pragma unroll
    for (int v = 0; v < 5; ++v)
#pragma unroll
        for (int j = 0; j < 4; ++j) acc[v][j] = 0.f;
    const float* wp = P->in[4] + (size_t)layer * 2048 * 12288 + (size_t)(ks * 128) * 12288 + col0 + 4 * cgp;
#pragma unroll 8
    for (int k = 0; k < 128; ++k) {
        const f32x4 w = *(const f32x4*)(wp + (size_t)k * 12288);
#pragma unroll
        for (int v = 0; v < 5; ++v) { const float s = sv[v * 2048 + ks * 128 + k]; acc[v][0] += s * w.x; acc[v][1] += s * w.y; acc[v][2] += s * w.z; acc[v][3] += s * w.w; }
    }
#pragma unroll
    for (int v = 0; v < 5; ++v)
#pragma unroll
        for (int j = 0; j < 4; ++j) part[(ks * 5 + v) * 128 + 4 * cgp + j] = acc[v][j];
    __syncthreads();
    float* mods = (float*)(lws(P->ws) + OFF_MODS);
    for (int o = tid; o < 640; o += 512) { const int v = o >> 7, cc = o & 127; float s = P->in[5][layer * 12288 + col0 + cc];
#pragma unroll
        for (int q = 0; q < 16; ++q) s += part[(q * 5 + v) * 128 + cc];
        mods[(size_t)(layer * 5 + v) * 12288 + col0 + cc] = s; }
    __syncthreads();
}
__device__ __forceinline__ void phase_prep(PP P, LAS unsigned char* lds, int G) {
    const int tid = otid(), wid = tid >> 6, lane = tid & 63, bid = obid();
    for (int it = bid; it < 192; it += G) ada_item(P, lds, it);
    { float* tswa = (float*)(lws(P->ws) + OFF_TSWA); float* tmla = (float*)(lws(P->ws) + OFF_TMLA);
      for (int i = bid * 512 + tid; i < 2048 * 64; i += G * 512) { const int t = i >> 6, pi = i & 63, j = pi & 31; const float inv = exp2f(-(float)j * (13.287712379549449f / 32.f));
          const float ang = (float)(pi < 32 ? (t >> 6) : (t & 63)) * inv; tswa[2 * i] = cosf(ang); tswa[2 * i + 1] = sinf(ang); }
      for (int i = bid * 512 + tid; i < 2048 * 32; i += G * 512) { const int t = i >> 5, pi = i & 31, j = pi & 15; const float inv = exp2f(-(float)j * (13.287712379549449f / 16.f));
          const float ang = (float)(pi < 16 ? (t >> 6) : (t & 63)) * inv; tmla[2 * i] = cosf(ang); tmla[2 * i + 1] = sinf(ang); } }
    LAS float* scr = (LAS float*)(lds + wid * 8704);
    const int gw = bid * NWAVES + wid, NGW = G * NWAVES;
    constexpr int I_IN = 32 * 98, I_OUT = 32 * 64, I_UQ = 12 * 36, I_UKV = 8 * 48, I_GLU = 8 * 16, I_1 = 32 * 256, I_2 = 128 * 64;
    constexpr int I_L = I_IN + I_OUT + I_UQ + I_UKV + I_GLU + I_1 + I_2;
    auto do_item = [&](int it) {
        const int layer = it / I_L; int r = it % I_L;
        unsigned char* wl = lws(P->ws) + (size_t)layer * WL_STRIDE;
        if (r < I_IN) { transpose_item(P->in[10] + (size_t)layer * DM * INW, DM, INW, 98, (bf16_t*)(wl + OFF_WIN), 1, nullptr, scr, r, lane); return; } r -= I_IN;
        if (r < I_OUT) { transpose_item(P->in[11] + (size_t)layer * DM * DM, DM, DM, 64, (bf16_t*)(wl + OFF_WOUT), 0, nullptr, scr, r, lane); return; } r -= I_OUT;
        if (r < I_UQ) { transpose_item(P->in[24] + (size_t)layer * 768 * UQW, 768, UQW, 36, (bf16_t*)(wl + OFF_WUQ), 2, P->in[23] + layer * 768, scr, r, lane); return; } r -= I_UQ;
        if (r < I_UKV) { transpose_item(P->in[26] + (size_t)layer * 512 * UKVW, 512, UKVW, 48, (bf16_t*)(wl + OFF_WUKV), 0, P->in[25] + layer * 512, scr, r, lane); return; } r -= I_UKV;
        if (r < I_GLU) { transpose_item(P->in[20] + (size_t)layer * 512 * 512, 512, 512, 16, (bf16_t*)(wl + OFF_WGLU), 0, nullptr, scr, r, lane); return; } r -= I_GLU;
        if (r < I_1) { transpose_item(P->in[27] + (size_t)layer * DM * DFF, DM, DFF, 256, (bf16_t*)(wl + OFF_W1), 0, nullptr, scr, r, lane); return; } r -= I_1;
        transpose_item(P->in[28] + (size_t)layer * DFF * DM, DFF, DM, 64, (bf16_t*)(wl + OFF_W2), 0, nullptr, scr, r, lane);
    };
    if (G == 256) {
        const int kmax = bid < 192 ? 18 : 22;
        for (int k = 0; k < kmax; ++k) { const int it = gw + k * NGW; if (it < 2 * I_L) do_item(it); }
        if (bid >= 192) { const int w2 = gw - 1536;
            for (int m = 0; m < 12; ++m) { const int j = w2 + m * 512, it = (j % 1536) + (18 + j / 1536) * NGW; if (it < 2 * I_L) do_item(it); } }
    } else {
        for (int it = gw; it < 2 * I_L; it += NGW) do_item(it);
    }
}

struct RowArgs { const void* xin; bool xin_bf; void* xout; bool xout_bf; const bf16_t* o; int nparts; const float* gate; const float* gpost; const float* gpre; const float* shift; const float* scale; bf16_t* hout; };
struct RowParams { f32x4 gg[8], ga[8], sh[8]; };
__device__ __forceinline__ void row_params(const RowArgs& a, int lane, RowParams& p) {
#pragma unroll
    for (int j = 0; j < 8; ++j) { const int d = 4 * (lane + 64 * j);
        if (a.o) p.gg[j] = *(const f32x4*)(a.gate + d) * *(const f32x4*)(a.gpost + d);
        if (a.hout) { p.ga[j] = *(const f32x4*)(a.gpre + d) * (*(const f32x4*)(a.scale + d) + 1.f); p.sh[j] = *(const f32x4*)(a.shift + d); } }
}
template <int NR, bool SH>
__device__ __forceinline__ void row_stage(const RowArgs (&A)[NR], int lane, const RowParams& PR) {
    f32x4 v[NR][8], ov[NR][8];
#pragma unroll
    for (int r = 0; r < NR; ++r)
#pragma unroll
        for (int j = 0; j < 8; ++j) {
            if (A[r].xin_bf) { const u32x2 w = *(const u32x2*)((const bf16_t*)A[r].xin + 4 * (lane + 64 * j)); v[r][j] = (f32x4){bf_lo(w.x), bf_hi(w.x), bf_lo(w.y), bf_hi(w.y)}; }
            else v[r][j] = *(const f32x4*)((const float*)A[r].xin + 4 * (lane + 64 * j)); }
    if (A[0].o) {
#pragma unroll
        for (int r = 0; r < NR; ++r) {
#pragma unroll
            for (int j = 0; j < 8; ++j) { const u32x2 w = *(const u32x2*)(A[r].o + 4 * (lane + 64 * j)); ov[r][j] = (f32x4){bf_lo(w.x), bf_hi(w.x), bf_lo(w.y), bf_hi(w.y)}; }
            if (A[r].nparts == 8) {
#pragma unroll
                for (int j = 0; j < 8; ++j) { u32x2 w2[7];
#pragma unroll
                    for (int pp = 0; pp < 7; ++pp) w2[pp] = *(const u32x2*)(A[r].o + (size_t)(pp + 1) * MC * DM + 4 * (lane + 64 * j));
#pragma unroll
                    for (int pp = 0; pp < 7; ++pp) ov[r][j] += (f32x4){bf_lo(w2[pp].x), bf_hi(w2[pp].x), bf_lo(w2[pp].y), bf_hi(w2[pp].y)}; }
            }
        }
        float rstd[NR];
#pragma unroll
        for (int r = 0; r < NR; ++r) { float ss = 0.f;
#pragma unroll
            for (int j = 0; j < 8; ++j) ss += ov[r][j].x * ov[r][j].x + ov[r][j].y * ov[r][j].y + ov[r][j].z * ov[r][j].z + ov[r][j].w * ov[r][j].w;
            rstd[r] = rsqrtf(wave_sum(ss) * (1.f / DM) + EPSN); }
#pragma unroll
        for (int j = 0; j < 8; ++j) {
            f32x4 gg[NR];
#pragma unroll
            for (int r = 0; r < NR; ++r) if (!SH) gg[r] = *(const f32x4*)(A[r].gate + 4 * (lane + 64 * j)) * *(const f32x4*)(A[r].gpost + 4 * (lane + 64 * j));
#pragma unroll
            for (int r = 0; r < NR; ++r) v[r][j] += (SH ? PR.gg[j] : gg[r]) * (ov[r][j] * rstd[r]);
        }
    }
    if (A[0].xout) {
#pragma unroll
        for (int r = 0; r < NR; ++r)
#pragma unroll
            for (int j = 0; j < 8; ++j) {
                if (A[r].xout_bf) { u32x2 w; w.x = cvt_pk_bf16(v[r][j].x, v[r][j].y); w.y = cvt_pk_bf16(v[r][j].z, v[r][j].w); *(u32x2*)((bf16_t*)A[r].xout + 4 * (lane + 64 * j)) = w; }
                else *(f32x4*)((float*)A[r].xout + 4 * (lane + 64 * j)) = v[r][j]; }
    }
    if (A[0].hout) {
        float rstd[NR];
#pragma unroll
        for (int r = 0; r < NR; ++r) { float ss = 0.f;
#pragma unroll
            for (int j = 0; j < 8; ++j) ss += v[r][j].x * v[r][j].x + v[r][j].y * v[r][j].y + v[r][j].z * v[r][j].z + v[r][j].w * v[r][j].w;
            rstd[r] = rsqrtf(wave_sum(ss) * (1.f / DM) + EPSN); }
#pragma unroll
        for (int j = 0; j < 8; ++j) { const int d = 4 * (lane + 64 * j);
            f32x4 ga[NR], sh[NR];
#pragma unroll
            for (int r = 0; r < NR; ++r) if (!SH) { ga[r] = *(const f32x4*)(A[r].gpre + d) * (*(const f32x4*)(A[r].scale + d) + 1.f); sh[r] = *(const f32x4*)(A[r].shift + d); }
#pragma unroll
            for (int r = 0; r < NR; ++r) { const f32x4 h = v[r][j] * rstd[r] * (SH ? PR.ga[j] : ga[r]) + (SH ? PR.sh[j] : sh[r]);
                u32x2 w; w.x = cvt_pk_bf16(h.x, h.y); w.y = cvt_pk_bf16(h.z, h.w); *(u32x2*)(A[r].hout + d) = w; }
        }
    }
}
__device__ __forceinline__ RowArgs row_args(PP P, int stage, int layer, int row) {
    const float* mods = (const float*)(lws(P->ws) + OFF_MODS);
    bf16_t* XS = (bf16_t*)(lws(P->ws) + OFF_XS); bf16_t* H = (bf16_t*)(lws(P->ws) + OFF_H); const bf16_t* O = (const bf16_t*)(lws(P->ws) + OFF_O); const bf16_t* OP = (const bf16_t*)(lws(P->ws) + OFF_OPART);
    const int v = row < ML ? (row >> 11) : 4;
    const float* xorig = row < ML ? P->in[0] + (size_t)row * DM : P->in[2] + (size_t)(row - ML) * DM;
    const float* md = mods + (size_t)(layer * 5 + v) * 12288;
    const bf16_t* orow = row < ML ? O + (size_t)row * DM : OP + (size_t)(row - ML) * DM; const int np = row < ML ? 1 : 8;
    RowArgs a;
    bf16_t* xs = XS + (size_t)row * DM; bf16_t* hrow = H + (size_t)row * DM;
    if (stage == 0) a = RowArgs{xorig, false, nullptr, false, nullptr, 1, nullptr, nullptr, P->in[6], md, md + DM, hrow};
    else if (stage == 1) { if (layer == 0) a = RowArgs{xorig, false, xs, true, orow, np, md + 2 * DM, P->in[7], P->in[8], md + 3 * DM, md + 4 * DM, hrow};
                           else a = RowArgs{xs, true, xs, true, orow, np, md + 2 * DM, P->in[7] + DM, P->in[8] + DM, md + 3 * DM, md + 4 * DM, hrow}; }
    else if (layer == 0) { const float* md1 = mods + (size_t)(5 + v) * 12288;
        a = RowArgs{xs, true, xs, true, orow, np, md + 5 * DM, P->in[9], P->in[6] + DM, md1, md1 + DM, hrow}; }
    else a = RowArgs{xs, true, P->out + (size_t)row * DM, false, orow, np, md + 5 * DM, P->in[9] + DM, nullptr, nullptr, nullptr, nullptr};
    return a;
}
__device__ __forceinline__ void phase_rows(PP P, int stage, int layer, int G) {
    const int tid = otid(), wid = tid >> 6, lane = tid & 63;
    const int NW = G * NWAVES, gw = obid() * NWAVES + wid;
#pragma unroll 1
    for (int row0 = 4 * gw; row0 < ML; row0 += 4 * NW) {
        RowParams PR; row_params(row_args(P, stage, layer, row0), lane, PR);
#pragma unroll 1
        for (int row = row0; row < row0 + 4; ++row) { const RowArgs A[1] = {row_args(P, stage, layer, row)}; row_stage<1, true>(A, lane, PR); } }
    if (stage == 0 || layer == 0) {
#pragma unroll 1
        for (int row = ML + gw; row < MT; row += NW) { const RowArgs A[1] = {row_args(P, stage, layer, row)}; RowParams PR; row_stage<1, false>(A, lane, PR); }
    }
}

__device__ __forceinline__ int s5_row(int b, int dir, int s) {
    if (dir == 0) return s < CTXL ? ML + b * CTXL + s : b * SEQ + (s - CTXL);
    return s < CTXL ? ML + b * CTXL + (CTXL - 1 - s) : b * SEQ + (SEQ - 1 - (s - CTXL));
}
__device__ __forceinline__ int s5_key(int dir, int s) { return dir == 0 ? s : (s < CTXL ? CTXL - 1 - s : CTXL + SEQ - 1 - (s - CTXL)); }
__device__ __forceinline__ void s5_lam(PP P, int pidx, int n, float dt, float& lr, float& li, float& fr, float& fi) {
    const float are = P->in[12][pidx * 64 + n], aim = P->in[13][pidx * 64 + n];
    const float mag = expf(are * dt); lr = mag * cosf(aim * dt); li = mag * sinf(aim * dt);
    const float den = are * are + aim * aim, nr = lr - 1.f;
    fr = (nr * are + li * aim) / den; fi = (li * are - nr * aim) / den;
}
__device__ __forceinline__ void s5_unit(PP P, LAS unsigned char* lds, int layer, int unit) {
    const int tid = otid(), wid = tid >> 6, lane = tid & 63, c = lane & 15, g = lane >> 4;
    const int b = unit >> 6, grp = (unit >> 1) & 31, dir = unit & 1;
    const int pidx = (layer * 2 + dir) * 32 + grp;
    const bf16_t* Ug = (const bf16_t*)(lws(P->ws) + OFF_U) + (size_t)(b * 32 + grp) * NKEY * 16;
    float* YD = (float*)(lws(P->ws) + OFF_YDIR) + (size_t)dir * MT * 512;
    LAS float* ends = (LAS float*)lds;
    const float dt = expf(P->in[14][pidx]);
    LAS float* lamt = (LAS float*)(lds + 65536);
    if (tid < 64) { float a0, a1, a2, a3; s5_lam(P, pidx, tid, dt, a0, a1, a2, a3); *(LAS f32x4*)(lamt + 4 * tid) = (f32x4){a0, a1, a2, a3}; }
    __syncthreads();
    f32x4 lr[4], li[4];
#pragma unroll
    for (int t4 = 0; t4 < 4; ++t4)
#pragma unroll
        for (int r = 0; r < 4; ++r) { const f32x4 q = *(const LAS f32x4*)(lamt + 4 * (16 * t4 + 4 * g + r)); lr[t4][r] = q.x; li[t4][r] = q.y; }
    bf16x8 bfr[8];
#pragma unroll
    for (int t4 = 0; t4 < 4; ++t4) {
        const int n = 16 * t4 + c; const f32x4 q = *(const LAS f32x4*)(lamt + 4 * n); const float fr = q.z, fi = q.w;
        u32x4 wr = (u32x4){0u, 0u, 0u, 0u}, wi = (u32x4){0u, 0u, 0u, 0u};
        if (g < 2) {
            const float* bre = P->in[15] + ((size_t)pidx * 64 + n) * 16 + 8 * g; const float* bim = P->in[16] + ((size_t)pidx * 64 + n) * 16 + 8 * g;
            const f32x4 r0 = *(const f32x4*)bre, r1 = *(const f32x4*)(bre + 4), i0 = *(const f32x4*)bim, i1 = *(const f32x4*)(bim + 4);
            const f32x4 ar0 = r0 * fr - i0 * fi, ar1 = r1 * fr - i1 * fi, ai0 = i0 * fr + r0 * fi, ai1 = i1 * fr + r1 * fi;
            wr = pack8(ar0, ar1); wi = pack8(ai0, ai1);
        }
        bfr[t4] = __builtin_bit_cast(bf16x8, wr); bfr[4 + t4] = __builtin_bit_cast(bf16x8, wi);
    }
    bf16x8 cfr[4];
#pragma unroll
    for (int f = 0; f < 4; ++f) {
        const float* cp = (f < 2 ? P->in[17] : P->in[18]) + ((size_t)pidx * 16 + c) * 64 + 32 * (f & 1) + 4 * g;
        f32x4 a = *(const f32x4*)cp, bq = *(const f32x4*)(cp + 16);
        if (f >= 2) { a = -a; bq = -bq; }
        cfr[f] = __builtin_bit_cast(bf16x8, pack8(a, bq));
    }
    const int seg = wid * 16 + c, s0 = 18 * seg;
    f32x4 hr[4], hi[4];
#pragma unroll
    for (int t4 = 0; t4 < 4; ++t4)
#pragma unroll
        for (int r = 0; r < 4; ++r) { hr[t4][r] = 0.f; hi[t4][r] = 0.f; }
    const f32x4 zero4 = (f32x4){0.f, 0.f, 0.f, 0.f};
#pragma unroll 3
    for (int t = 0; t < 18; ++t) {
        u32x4 uw = (u32x4){0u, 0u, 0u, 0u};
        if (g < 2) uw = *(const u32x4*)(Ug + (size_t)s5_key(dir, s0 + t) * 16 + 8 * g);
        const bf16x8 uf = __builtin_bit_cast(bf16x8, uw);
#pragma unroll
        for (int t4 = 0; t4 < 4; ++t4) {
            const f32x4 cr = lr[t4] * hr[t4] - li[t4] * hi[t4], ci = lr[t4] * hi[t4] + li[t4] * hr[t4];
            hr[t4] = __builtin_amdgcn_mfma_f32_16x16x32_bf16(bfr[t4], uf, cr, 0, 0, 0);
            hi[t4] = __builtin_amdgcn_mfma_f32_16x16x32_bf16(bfr[4 + t4], uf, ci, 0, 0, 0); }
    }
#pragma unroll
    for (int t4 = 0; t4 < 4; ++t4) {
        *(LAS f32x4*)(ends + seg * 128 + 16 * t4 + 4 * g) = hr[t4];
        *(LAS f32x4*)(ends + seg * 128 + 64 + 16 * t4 + 4 * g) = hi[t4];
    }
    __syncthreads();
    if (wid == 0) {
        const f32x4 q = *(const LAS f32x4*)(lamt + 4 * lane); const float l0 = q.x, l1 = q.y;
        float p2r = l0 * l0 - l1 * l1, p2i = 2.f * l0 * l1, qr = p2r, qi = p2i;
#pragma unroll
        for (int i = 0; i < 3; ++i) { const float a = qr * qr - qi * qi, d = 2.f * qr * qi; qr = a; qi = d; }
        const float Lr = qr * p2r - qi * p2i, Li = qr * p2i + qi * p2r;
        float ir = 0.f, ii = 0.f;
#pragma unroll 4
        for (int j = 0; j < 128; ++j) { const float er = ends[j * 128 + lane], ei = ends[j * 128 + 64 + lane];
            ends[j * 128 + lane] = ir; ends[j * 128 + 64 + lane] = ii;
            const float a = Lr * ir - Li * ii + er, d = Lr * ii + Li * ir + ei; ir = a; ii = d; }
    }
    __syncthreads();
#pragma unroll
    for (int t4 = 0; t4 < 4; ++t4) {
        const f32x4 a = *(const LAS f32x4*)(ends + seg * 128 + 16 * t4 + 4 * g), d = *(const LAS f32x4*)(ends + seg * 128 + 64 + 16 * t4 + 4 * g);
#pragma unroll
        for (int r = 0; r < 4; ++r) { hr[t4][r] = a[r]; hi[t4][r] = d[r]; }
    }
#pragma unroll 3
    for (int t = 0; t < 18; ++t) {
        const int row = s5_row(b, dir, s0 + t);
        u32x4 uw = (u32x4){0u, 0u, 0u, 0u};
        if (g < 2) uw = *(const u32x4*)(Ug + (size_t)s5_key(dir, s0 + t) * 16 + 8 * g);
        const bf16x8 uf = __builtin_bit_cast(bf16x8, uw);
#pragma unroll
        for (int t4 = 0; t4 < 4; ++t4) {
            const f32x4 cr = lr[t4] * hr[t4] - li[t4] * hi[t4], ci = lr[t4] * hi[t4] + li[t4] * hr[t4];
            hr[t4] = __builtin_amdgcn_mfma_f32_16x16x32_bf16(bfr[t4], uf, cr, 0, 0, 0);
            hi[t4] = __builtin_amdgcn_mfma_f32_16x16x32_bf16(bfr[4 + t4], uf, ci, 0, 0, 0); }
        f32x4 y = zero4;
#pragma unroll
        for (int f = 0; f < 4; ++f) {
            const int ta = 2 * (f & 1), tb = ta + 1;
            u32x4 w;
            if (f < 2) { w.x = cvt_pk_bf16(hr[ta][0], hr[ta][1]); w.y = cvt_pk_bf16(hr[ta][2], hr[ta][3]); w.z = cvt_pk_bf16(hr[tb][0], hr[tb][1]); w.w = cvt_pk_bf16(hr[tb][2], hr[tb][3]); }
            else       { w.x = cvt_pk_bf16(hi[ta][0], hi[ta][1]); w.y = cvt_pk_bf16(hi[ta][2], hi[ta][3]); w.z = cvt_pk_bf16(hi[tb][0], hi[tb][1]); w.w = cvt_pk_bf16(hi[tb][2], hi[tb][3]); }
            y = __builtin_amdgcn_mfma_f32_16x16x32_bf16(cfr[f], __builtin_bit_cast(bf16x8, w), y, 0, 0, 0);
        }
        *(f32x4*)(YD + (size_t)row * 512 + grp * 16 + 4 * g) = y;
    }
    __syncthreads();
}
__device__ __forceinline__ void phase_s5(PP P, LAS unsigned char* lds, int layer, int G) {
    for (int u = obid(); u < 256; u += G) s5_unit(P, lds, layer, u);
    const int tid = otid(), wid = tid >> 6, lane = tid & 63;
    const bf16_t* CQ = (const bf16_t*)(lws(P->ws) + OFF_CQ); const bf16_t* CKV = (const bf16_t*)(lws(P->ws) + OFF_CKV);
    float* RSQ = (float*)(lws(P->ws) + OFF_RSQ); float* RSKV = (float*)(lws(P->ws) + OFF_RSKV);
    for (int row = obid() * NWAVES + wid; row < MT; row += G * NWAVES) {
        float s = 0.f;
#pragma unroll
        for (int j = 0; j < 3; ++j) { const u32x2 w = *(const u32x2*)(CQ + (size_t)row * 768 + 4 * (lane + 64 * j)); const float a = bf_lo(w.x), b = bf_hi(w.x), c = bf_lo(w.y), d = bf_hi(w.y); s += a * a + b * b + c * c + d * d; }
        s = wave_sum(s);
        float s2 = 0.f;
        { const u32x4 w = *(const u32x4*)(CKV + (size_t)row * 512 + 8 * lane);
          float a;
          a = bf_lo(w.x); s2 += a * a; a = bf_hi(w.x); s2 += a * a; a = bf_lo(w.y); s2 += a * a; a = bf_hi(w.y); s2 += a * a;
          a = bf_lo(w.z); s2 += a * a; a = bf_hi(w.z); s2 += a * a; a = bf_lo(w.w); s2 += a * a; a = bf_hi(w.w); s2 += a * a; }
        s2 = wave_sum(s2);
        if (lane == 0) { RSQ[row] = rsqrtf(s * (1.f / 768.f) + EPSN); RSKV[row] = rsqrtf(s2 * (1.f / 512.f) + EPSN); }
    }
}
__device__ __forceinline__ void phase_ycombine(PP P, int layer, int G) {
    const bf16_t* U = (const bf16_t*)(lws(P->ws) + OFF_U); const float* YD = (const float*)(lws(P->ws) + OFF_YDIR); bf16_t* Gb = (bf16_t*)(lws(P->ws) + OFF_G);
    const float* dsk = P->in[19] + layer * 512;
    for (int i = obid() * 512 + otid(); i < MT * 128; i += G * 512) {
        const int row = i >> 7, c = (i & 127) * 4;
        bool lat; int bb, tt, kidx; row_decode(row, lat, bb, tt, kidx);
        const u32x2 w = *(const u32x2*)(U + (((size_t)(bb * 32 + (c >> 4)) * NKEY + kidx) << 4) + (c & 15));
        const f32x4 yf = *(const f32x4*)(YD + (size_t)row * 512 + c), yb = *(const f32x4*)(YD + (size_t)(MT + row) * 512 + c), d = *(const f32x4*)(dsk + c);
        f32x4 y = (f32x4){bf_lo(w.x), bf_hi(w.x), bf_lo(w.y), bf_hi(w.y)} * d + yf + yb;
#pragma unroll
        for (int e = 0; e < 4; ++e) { const float x = y[e], z = 0.7978845608028654f * (x + 0.044715f * x * x * x); const float th = 1.f - 2.f / (1.f + __expf(2.f * z)); y[e] = 0.5f * x * (1.f + th); }
        u32x2 o; o.x = cvt_pk_bf16(y.x, y.y); o.y = cvt_pk_bf16(y.z, y.w); *(u32x2*)(Gb + (size_t)row * 512 + c) = o;
    }
}

template <int NKR>
__device__ __forceinline__ void attn_block(LAS unsigned char* lds,
                                           const bf16_t* qa, int qa_stride, const bf16_t* qb, int qb_stride,
                                           const bf16_t* ka, const bf16_t* kb, const bf16_t* vt,
                                           int n0, int k1_beg, int n1, int qpos0,
                                           float cscale, float m_init, float l_init, bf16_t* out, int out_stride) {
    constexpr int KROWB = (128 + 32 * NKR) * 2 + 32, VROWB = 160,   VOFF = 64 * KROWB, BUFB = VOFF + 128 * VROWB;
    const int tid = otid(), wid = __builtin_amdgcn_readfirstlane(tid >> 6), lane = tid & 63, fr = lane & 15, g = lane >> 4;
    const int nt = n0 + n1;
    bf16x8 qf[2][4 + NKR];
#pragma unroll
    for (int qt = 0; qt < 2; ++qt) {
#pragma unroll
        for (int ks = 0; ks < 4; ++ks) qf[qt][ks] = *(const bf16x8*)(qa + (size_t)(wid * 32 + qt * 16 + fr) * qa_stride + ks * 32 + 8 * g);
#pragma unroll
        for (int ks = 0; ks < NKR; ++ks) qf[qt][4 + ks] = *(const bf16x8*)(qb + (size_t)(wid * 32 + qt * 16 + fr) * qb_stride + ks * 32 + 8 * g);
    }
    f32x4 oacc[8][2];
#pragma unroll
    for (int dt = 0; dt < 8; ++dt) { oacc[dt][0] = (f32x4){0.f, 0.f, 0.f, 0.f}; oacc[dt][1] = (f32x4){0.f, 0.f, 0.f, 0.f}; }
    float mrun[2] = {m_init, m_init}, lrun[2] = {g == 0 ? l_init : 0.f, g == 0 ? l_init : 0.f};
    u32x4 sk[2], sr, sv[2];
    const int krow = tid >> 4, kcc = tid & 15, rrow = tid >> 3, rcc = tid & 7;
#define ATT_LOADK(kb0) do { \
        sk[0] = *(const u32x4*)(ka + (size_t)((kb0) + krow) * 128 + kcc * 8); sk[1] = *(const u32x4*)(ka + (size_t)((kb0) + 32 + krow) * 128 + kcc * 8); \
        if (NKR) sr = *(const u32x4*)(kb + (size_t)((kb0) + rrow) * 64 + rcc * 8); } while (0)
#define ATT_STOREK(buf) do { LAS unsigned char* _b = lds + (buf) * BUFB; \
        *(LAS u32x4*)(_b + krow * KROWB + kcc * 16) = sk[0]; *(LAS u32x4*)(_b + (32 + krow) * KROWB + kcc * 16) = sk[1]; \
        if (NKR) *(LAS u32x4*)(_b + rrow * KROWB + 256 + rcc * 16) = sr; } while (0)
#define ATT_LOADV(kb0) do { \
        sv[0] = *(const u32x4*)(vt + (size_t)rrow * NKEY + (kb0) + rcc * 8); sv[1] = *(const u32x4*)(vt + (size_t)(64 + rrow) * NKEY + (kb0) + rcc * 8); } while (0)
#define ATT_STOREV(buf) do { LAS unsigned char* _b = lds + (buf) * BUFB; \
        *(LAS u32x4*)(_b + VOFF + rrow * VROWB + rcc * 16) = sv[0]; *(LAS u32x4*)(_b + VOFF + (64 + rrow) * VROWB + rcc * 16) = sv[1]; } while (0)
    { const int k00 = n0 > 0 ? 0 : k1_beg; ATT_LOADK(k00); ATT_STOREK(0); ATT_LOADV(k00); ATT_STOREV(0); }
    __syncthreads();
#pragma unroll 1
    for (int i = 0; i < nt; ++i) {
        const int kbase = i < n0 ? 64 * i : k1_beg + 64 * (i - n0);
        const bool msk = i >= n0;
        const int kn = (i + 1) < n0 ? 64 * (i + 1) : k1_beg + 64 * (i + 1 - n0);
        bool active = true;
        if (msk) { const int kp = kbase - CTXL, qw = qpos0 + 32 * wid; active = (kp < qw + 160) && (kp + 64 > qw - 128); }
        const LAS unsigned char* kbuf = lds + (i & 1) * BUFB; const LAS unsigned char* vbuf = kbuf + VOFF;
        f32x4 st[4][2];
        if (active) {
#pragma unroll
            for (int kt = 0; kt < 4; ++kt) { st[kt][0] = (f32x4){0.f, 0.f, 0.f, 0.f}; st[kt][1] = (f32x4){0.f, 0.f, 0.f, 0.f}; }
            bf16x8 kf[2][4];
#pragma unroll
            for (int kt = 0; kt < 4; ++kt) kf[0][kt] = *(const LAS bf16x8*)(kbuf + (kt * 16 + fr) * KROWB + g * 16);
#pragma unroll
            for (int ks = 0; ks < 4 + NKR; ++ks) {
                if (ks + 1 < 4 + NKR) {
#pragma unroll
                    for (int kt = 0; kt < 4; ++kt) kf[(ks + 1) & 1][kt] = *(const LAS bf16x8*)(kbuf + (kt * 16 + fr) * KROWB + (ks + 1) * 64 + g * 16);
                }
#pragma unroll
                for (int kt = 0; kt < 4; ++kt) {
                    st[kt][0] = __builtin_amdgcn_mfma_f32_16x16x32_bf16(kf[ks & 1][kt], qf[0][ks], st[kt][0], 0, 0, 0);
                    st[kt][1] = __builtin_amdgcn_mfma_f32_16x16x32_bf16(kf[ks & 1][kt], qf[1][ks], st[kt][1], 0, 0, 0); }
                __builtin_amdgcn_sched_barrier(0);
            }
        }
        if (i + 1 < nt) { ATT_LOADK(kn); ATT_LOADV(kn); }
        if (active) {
            bf16x8 pb[2][2];
#pragma unroll
            for (int qt = 0; qt < 2; ++qt) {
                float tv[4][4]; float mxr = -3.0e38f;
#pragma unroll
                for (int kt = 0; kt < 4; ++kt)
#pragma unroll
                    for (int r = 0; r < 4; ++r) { float t = st[kt][qt][r];
                        if (msk) { const int kpos = kbase + kt * 16 + 4 * g + r - CTXL, qpos = qpos0 + wid * 32 + qt * 16 + fr; const int dlt = qpos - kpos; if (dlt > 128 || dlt < -128) t = -1e30f; }
                        tv[kt][r] = t; mxr = fmaxf(mxr, t); }
                mxr = fmaxf(mxr, __shfl_xor(mxr, 16)); mxr = fmaxf(mxr, __shfl_xor(mxr, 32));
                const float mxs = mxr * cscale;
                float mx = mrun[qt], alpha = 1.f;
                if (__any(mxs > mrun[qt] + 8.f)) {
                    mx = fmaxf(mrun[qt], mxs); alpha = __builtin_amdgcn_exp2f(mrun[qt] - mx); mrun[qt] = mx;
#pragma unroll
                    for (int dt = 0; dt < 8; ++dt) oacc[dt][qt] *= alpha;
                }
                float ps = 0.f;
#pragma unroll
                for (int kt = 0; kt < 4; ++kt)
#pragma unroll
                    for (int r = 0; r < 4; ++r) { tv[kt][r] = __builtin_amdgcn_exp2f(__builtin_fmaf(tv[kt][r], cscale, -mx)); ps += tv[kt][r]; }
                lrun[qt] = lrun[qt] * alpha + ps;
#pragma unroll
                for (int G2 = 0; G2 < 2; ++G2) { u32x4 w; w.x = cvt_pk_bf16(tv[2 * G2][0], tv[2 * G2][1]); w.y = cvt_pk_bf16(tv[2 * G2][2], tv[2 * G2][3]);
                    w.z = cvt_pk_bf16(tv[2 * G2 + 1][0], tv[2 * G2 + 1][1]); w.w = cvt_pk_bf16(tv[2 * G2 + 1][2], tv[2 * G2 + 1][3]); pb[qt][G2] = __builtin_bit_cast(bf16x8, w); }
            }
            __builtin_amdgcn_sched_barrier(0);
            bf16x8 vf[2][2];
#pragma unroll
            for (int q = 0; q < 2; ++q) vf[0][q] = *(const LAS bf16x8*)(vbuf + fr * VROWB + q * 64 + g * 16);
#pragma unroll
            for (int dt = 0; dt < 8; ++dt) {
                if (dt + 1 < 8) {
#pragma unroll
                    for (int q = 0; q < 2; ++q) vf[(dt + 1) & 1][q] = *(const LAS bf16x8*)(vbuf + ((dt + 1) * 16 + fr) * VROWB + q * 64 + g * 16);
                }
#pragma unroll
                for (int q = 0; q < 2; ++q) {
                    oacc[dt][0] = __builtin_amdgcn_mfma_f32_16x16x32_bf16(vf[dt & 1][q], pb[0][q], oacc[dt][0], 0, 0, 0);
                    oacc[dt][1] = __builtin_amdgcn_mfma_f32_16x16x32_bf16(vf[dt & 1][q], pb[1][q], oacc[dt][1], 0, 0, 0); }
                __builtin_amdgcn_sched_barrier(0);
            }
        }
        if (i + 1 < nt) { ATT_STOREK((i + 1) & 1); ATT_STOREV((i + 1) & 1); }
        __syncthreads();
    }
#undef ATT_LOADK
#undef ATT_STOREK
#undef ATT_LOADV
#undef ATT_STOREV
#pragma unroll
    for (int qt = 0; qt < 2; ++qt) {
        float l = lrun[qt]; l += __shfl_xor(l, 16); l += __shfl_xor(l, 32);
        const float inv = 1.f / l;
#pragma unroll
        for (int dt = 0; dt < 8; ++dt) { const f32x4 o = oacc[dt][qt] * inv; u32x2 w; w.x = cvt_pk_bf16(o.x, o.y); w.y = cvt_pk_bf16(o.z, o.w);
            *(u32x2*)(out + (size_t)(wid * 32 + qt * 16 + fr) * out_stride + dt * 16 + 4 * g) = w; }
    }
}
constexpr float LOG2E = 1.4426950408889634f;
__device__ __forceinline__ void mla_unit(PP P, LAS unsigned char* lds, bool ctxq, int b, int h, int qb) {
    const bf16_t* QM = (const bf16_t*)(lws(P->ws) + OFF_QM); const bf16_t* KN = (const bf16_t*)(lws(P->ws) + OFF_KN); const bf16_t* KR = (const bf16_t*)(lws(P->ws) + OFF_KR);
    const bf16_t* VTM = (const bf16_t*)(lws(P->ws) + OFF_VTM); bf16_t* MIX = (bf16_t*)(lws(P->ws) + OFF_MIX);
    const int row0 = ctxq ? ML + b * CTXL : b * SEQ + 256 * qb;
    attn_block<2>(lds, QM + (size_t)row0 * UQW + h * 128, UQW, QM + (size_t)row0 * UQW + 768 + h * 64, UQW,
                  KN + (size_t)(b * 6 + h) * NKEY * 128, KR + (size_t)b * NKEY * 64, VTM + (size_t)(b * 6 + h) * 128 * NKEY,
                  ctxq ? 4 : 36, 0, 0, 0, 0.07216878364870322f * LOG2E, -1e30f, 0.f, MIX + (size_t)row0 * DM + 1280 + h * 128, DM);
}
__device__ __forceinline__ void swa_unit(PP P, LAS unsigned char* lds, int layer, bool ctxq, int b, int h, int qb) {
    const bf16_t* QS = (const bf16_t*)(lws(P->ws) + OFF_QS); const bf16_t* KS = (const bf16_t*)(lws(P->ws) + OFF_KS); const bf16_t* VTS = (const bf16_t*)(lws(P->ws) + OFF_VTS);
    bf16_t* MIX = (bf16_t*)(lws(P->ws) + OFF_MIX);
    const int q0 = 256 * qb, row0 = ctxq ? ML + b * CTXL : b * SEQ + q0;
    int k1 = 0, n1 = 0;
    if (!ctxq) { const int lo = q0 - 128 < 0 ? 0 : q0 - 128, hi = q0 + 384 > SEQ ? SEQ : q0 + 384; k1 = CTXL + lo; n1 = (hi - lo) >> 6; }
    const int kvh = h / 3;
    const float sink = P->in[22][layer * 6 + h] * LOG2E;
    attn_block<0>(lds, QS + (size_t)row0 * 768 + h * 128, 768, nullptr, 0,
                  KS + (size_t)(b * 2 + kvh) * NKEY * 128, nullptr, VTS + (size_t)(b * 2 + kvh) * 128 * NKEY,
                  4, k1, n1, q0, 0.08838834764831845f * LOG2E, sink, 1.f, MIX + (size_t)row0 * DM + 512 + h * 128, DM);
}
__device__ __forceinline__ void phase_att(PP P, LAS unsigned char* lds, int layer, bool need_ctx, int bid) {
    const int x = bid & 7;
    if (bid < 192) { const int j = bid >> 3, bh = x * 3 + (j >> 3); mla_unit(P, lds, false, bh / 6, bh % 6, j & 7); }
    else {
        const int y = (bid - 192) >> 3;
#pragma unroll 1
        for (int r = 0; r < 3; ++r) { const int bh = r * 8 + x; swa_unit(P, lds, layer, false, bh / 6, bh % 6, y); }
        const int j = bid - 192;
        if (need_ctx) { if (j < 24) mla_unit(P, lds, true, j / 6, j % 6, 0); else if (j < 48) swa_unit(P, lds, layer, true, (j - 24) / 6, (j - 24) % 6, 0); }
    }
}

__global__ void __launch_bounds__(512, 2) mega_fwd(Params Pval) {
#define P (kparams())
    extern __shared__ __attribute__((aligned(16))) unsigned char lds_raw[];
    LAS unsigned char* lds = (LAS unsigned char*)lds_raw;
    cg::grid_group grid = cg::this_grid();
    const int G = gridDim.x;
#define bid (obid())
    volatile LAS unsigned* xst = (volatile LAS unsigned*)(lds + 131072);
    if (threadIdx.x == 0) { xst[0] = 0u; xst[1] = 0u; }
    __syncthreads();
    (void)xcd_barrier_post((unsigned*)(lws(P->ws) + OFF_BAR), xst);
#define GRID_BARRIER() do { XcdBarrier xb_; xb_.bar = (unsigned*)(lws(P->ws) + OFF_BAR); xb_.x = xb_xcc_id(); xb_.st = (volatile LAS unsigned*)(lds + 131072); xcd_barrier(xb_); } while (0)

#ifndef SKIP_PREP
    phase_prep(P, lds, G);
#ifdef DUP_PREP
    __syncthreads();
    phase_prep(P, lds, G);
#endif
#endif
    if (P->ws == nullptr) grid.sync();
    GRID_BARRIER();
#ifndef SKIP_ROWS
    phase_rows(P, 0, 0, G);
#endif
    GRID_BARRIER();
#pragma unroll 1
    for (int layer = 0; layer < 2; ++layer) {
        const bool need_ctx = layer == 0;
        const int Mo = need_ctx ? MT : ML;
        { Gemm g{(const bf16_t*)(lws(P->ws) + OFF_H), (const bf16_t*)(lws(P->ws) + (size_t)layer * WL_STRIDE + OFF_WIN), MT, INWP, DM, DM, DM}; StaticOrder S; S.init(MT, INWP, G, bid);
          EpiInProj E{lws(P->ws)};
#ifndef SKIP_G1

#ifdef DUP_G1
_Pragma("unroll 1")
          for (int rep = 0; rep < 2; ++rep)
#endif
          pg8::gemm_phase(lds, g, S, E);

#endif
        }
        GRID_BARRIER();
#ifndef SKIP_S5
        phase_s5(P, lds, layer, G);
#ifdef DUP_S5
        phase_s5(P, lds, layer, G);
#endif
#endif
        GRID_BARRIER();
#ifndef SKIP_YC
        phase_ycombine(P, layer, G);
#endif
        { Gemm g{(const bf16_t*)(lws(P->ws) + OFF_CQ), (const bf16_t*)(lws(P->ws) + (size_t)layer * WL_STRIDE + OFF_WUQ), Mo, UQWP, 768, 768, 768}; StaticOrder S; S.init(Mo, UQWP, G, bid);
          EpiUQ E{(bf16_t*)(lws(P->ws) + OFF_QM), (const float*)(lws(P->ws) + OFF_RSQ), (const float*)(lws(P->ws) + OFF_TMLA)};

#ifdef DUP_G2
_Pragma("unroll 1")
          for (int rep = 0; rep < 2; ++rep)
#endif
          pg8::gemm_phase(lds, g, S, E);
 }
        { Gemm g{(const bf16_t*)(lws(P->ws) + OFF_CKV), (const bf16_t*)(lws(P->ws) + (size_t)layer * WL_STRIDE + OFF_WUKV), MT, UKVW, 512, 512, 512}; StaticOrder S; S.init(MT, UKVW, G, (bid + 76) % G);
          EpiUKV E{(bf16_t*)(lws(P->ws) + OFF_KN), (bf16_t*)(lws(P->ws) + OFF_VTM), (const float*)(lws(P->ws) + OFF_RSKV)};

#ifdef DUP_G2
_Pragma("unroll 1")
          for (int rep = 0; rep < 2; ++rep)
#endif
          pg8::gemm_phase(lds, g, S, E);
 }
        GRID_BARRIER();
        {
#ifndef SKIP_ATT
            phase_att(P, lds, layer, need_ctx, bid);
#ifdef DUP_ATT
            phase_att(P, lds, layer, need_ctx, bid);
#endif
#endif
            __syncthreads();
            Gemm g{(const bf16_t*)(lws(P->ws) + OFF_G), (const bf16_t*)(lws(P->ws) + (size_t)layer * WL_STRIDE + OFF_WGLU), Mo, 512, 512, 512, 512}; StaticOrder S; S.init(Mo, 512, 64, bid >= 192 ? ((bid - 192 + 16) & 63) : -1);
            EpiGLU E{(const bf16_t*)(lws(P->ws) + OFF_G), P->in[21] + layer * 512, (bf16_t*)(lws(P->ws) + OFF_MIX)};

#ifdef DUP_GLU
_Pragma("unroll 1")
          for (int rep = 0; rep < 2; ++rep)
#endif
          pg8::gemm_phase(lds, g, S, E);

        }
        GRID_BARRIER();
        { Gemm g{(const bf16_t*)(lws(P->ws) + OFF_MIX), (const bf16_t*)(lws(P->ws) + (size_t)layer * WL_STRIDE + OFF_WOUT), ML, DM, DM, DM, DM}; StaticOrder S; S.init(ML, DM, G, bid);
          EpiBf16Out E{(bf16_t*)(lws(P->ws) + OFF_O), DM, 0};
#ifdef DUP_G3
_Pragma("unroll 1")
          for (int rep = 0; rep < 2; ++rep)
#endif
          pg8::gemm_phase(lds, g, S, E);
        }
        if (need_ctx) { Gemm g{(const bf16_t*)(lws(P->ws) + OFF_MIX) + (size_t)ML * DM, (const bf16_t*)(lws(P->ws) + (size_t)layer * WL_STRIDE + OFF_WOUT), MC, DM, 256, DM, DM}; StaticOrder S; S.init(MC, DM, G, bid, 8);
          EpiBf16Out E{(bf16_t*)(lws(P->ws) + OFF_OPART), DM, (size_t)MC * DM};
#ifdef DUP_G3
_Pragma("unroll 1")
          for (int rep = 0; rep < 2; ++rep)
#endif
          pg8::gemm_phase(lds, g, S, E);
        }
        GRID_BARRIER();
#ifndef SKIP_ROWS
        phase_rows(P, 1, layer, G);
#ifdef DUP_ROWS1
        if (layer == 0) phase_rows(P, 1, layer, G);
#endif
#endif
        GRID_BARRIER();
        { Gemm g{(const bf16_t*)(lws(P->ws) + OFF_H), (const bf16_t*)(lws(P->ws) + (size_t)layer * WL_STRIDE + OFF_W1), Mo, DFF, DM, DM, DM}; StaticOrder S; S.init(Mo, DFF, G, bid);
          EpiSqRelu E{(bf16_t*)(lws(P->ws) + OFF_A1), DFF};

#ifdef DUP_FFN1
_Pragma("unroll 1")
          for (int rep = 0; rep < 2; ++rep)
#endif
          pg8::gemm_phase(lds, g, S, E);
 }
        GRID_BARRIER();
        { Gemm g{(const bf16_t*)(lws(P->ws) + OFF_A1), (const bf16_t*)(lws(P->ws) + (size_t)layer * WL_STRIDE + OFF_W2), ML, DM, DFF, DFF, DFF}; StaticOrder S; S.init(ML, DM, G, bid);
          EpiBf16Out E{(bf16_t*)(lws(P->ws) + OFF_O), DM, 0};
#ifndef SKIP_GEMM6
          pg8::gemm_phase(lds, g, S, E);
#ifdef DUP_FFN2
          pg8::gemm_phase(lds, g, S, E);
#endif
#endif
        }
        if (need_ctx) { Gemm g{(const bf16_t*)(lws(P->ws) + OFF_A1) + (size_t)ML * DFF, (const bf16_t*)(lws(P->ws) + (size_t)layer * WL_STRIDE + OFF_W2), MC, DM, 1024, DFF, DFF}; StaticOrder S; S.init(MC, DM, G, bid, 8);
          EpiBf16Out E{(bf16_t*)(lws(P->ws) + OFF_OPART), DM, (size_t)MC * DM};
#ifndef SKIP_GEMM6
          pg8::gemm_phase(lds, g, S, E);
#ifdef DUP_FFN2
          pg8::gemm_phase(lds, g, S, E);
#endif
#endif
        }
        GRID_BARRIER();
#ifndef SKIP_ROWS
        phase_rows(P, 2, layer, G);
#endif
#ifdef DUP_SYNC
        for (int rep = 0; rep < 5; ++rep) GRID_BARRIER();
#endif
        if (layer == 0) GRID_BARRIER();
    }
#undef P
#undef bid
}

extern "C" void kernel_launch(void* const* d_in, const int* in_sizes, int n_in, void* d_out, int out_size, void* d_ws, size_t ws_size, hipStream_t stream) {
    static int grid = 0;
    if (grid == 0) {
        if (n_in != 29 || out_size != ML * DM || ws_size < WS_END) { fprintf(stderr, "kernel_launch: unexpected shapes (n_in %d out %d ws %zu need %zu)\n", n_in, out_size, ws_size, (size_t)WS_END); grid = -1; return; }
        int dev = 0, cus = 0, per_cu = 0;
        hipGetDevice(&dev);
        hipDeviceGetAttribute(&cus, hipDeviceAttributeMultiprocessorCount, dev);
        if (hipFuncSetAttribute((const void*)mega_fwd, hipFuncAttributeMaxDynamicSharedMemorySize, LDS_BYTES) != hipSuccess) { fprintf(stderr, "kernel_launch: hipFuncSetAttribute failed\n"); grid = -1; return; }
        hipOccupancyMaxActiveBlocksPerMultiprocessor(&per_cu, (const void*)mega_fwd, 512, LDS_BYTES);
        if (per_cu < 1 || cus < 256) { fprintf(stderr, "kernel_launch: occupancy %d cus %d\n", per_cu, cus); grid = -1; return; }
        grid = 256;
    }
    if (grid < 0) return;
    if (hipMemsetAsync((char*)d_ws + OFF_BAR, 0, 16384, stream) != hipSuccess) { fprintf(stderr, "kernel_launch: memset failed\n"); return; }
    Params p{};
    for (int i = 0; i < 29; ++i) p.in[i] = (const float*)d_in[i];
    p.out = (float*)d_out; p.ws = (unsigned char*)d_ws;
    void* args[] = {&p};
    hipError_t e = hipLaunchCooperativeKernel((const void*)mega_fwd, dim3(grid), dim3(512), args, LDS_BYTES, stream);
    if (e != hipSuccess) fprintf(stderr, "cooperative launch failed: %s\n", hipGetErrorString(e));
}
```
